# Optimizing an MI355X kernel written in HIP

```python
import jax, jax.numpy as jnp
from jax import lax
import numpy as np

D_MODEL = 1024
BATCH = 8
SEQ = 8192
DEPTH = 1

CHUNK = 64
LEFT_CHUNKS = 8
BAND = (LEFT_CHUNKS + 1) * CHUNK
D_MIX = D_MODEL
D_ATTN = D_MIX // 2
D_CONV = D_MIX - D_ATTN
HEAD_DIM = 64
N_HEADS = D_ATTN // HEAD_DIM
CONV_GROUPS = 8
CONV_WIDTH = 3
MAX_REL = 128
N_REL = 2 * MAX_REL + 1
D_FF = 2816
N_SUB = 3
FFN_RES = 0.5
EPS = 1e-6
NEG_INF = -1e30

kernel_name = "hybrid_chunked_attn_shortconv_macaron_adaln"


def rms_norm(x, g):
    xf = x.astype(jnp.float32)
    y = xf * lax.rsqrt(jnp.mean(xf * xf, axis=-1, keepdims=True) + EPS)
    return (y * g.astype(jnp.float32)).astype(x.dtype)


def adaln_pre(x, g, shift, scale):
    return rms_norm(x, g) * (1.0 + scale[:, None, :]) + shift[:, None, :]


def swiglu(h, w_gu, w_down):
    gu = h @ w_gu
    g, u = jnp.split(gu, 2, axis=-1)
    return (jax.nn.silu(g) * u) @ w_down


def chunked_rel_attention(q, k, v, rel_bias):
    B, S, H, Dh = q.shape
    nc = S // CHUNK
    pad = LEFT_CHUNKS * CHUNK
    k_pad = jnp.pad(k, ((0, 0), (pad, 0), (0, 0), (0, 0)))
    v_pad = jnp.pad(v, ((0, 0), (pad, 0), (0, 0), (0, 0)))
    q_chunks = q.reshape(B, nc, CHUNK, H, Dh).transpose(1, 0, 2, 3, 4)
    a = jnp.arange(CHUNK)[:, None]
    j = jnp.arange(BAND)[None, :]
    rel_idx = jnp.clip(j - pad - a, -MAX_REL, MAX_REL) + MAX_REL
    bias = rel_bias[:, rel_idx].astype(jnp.float32)
    sm_scale = HEAD_DIM ** -0.5

    def one_chunk(args):
        i, qc = args
        start = i * CHUNK
        kb = lax.dynamic_slice_in_dim(k_pad, start, BAND, axis=1)
        vb = lax.dynamic_slice_in_dim(v_pad, start, BAND, axis=1)
        s = jnp.einsum('bqhd,bkhd->bhqk', qc, kb,
                       preferred_element_type=jnp.float32) * sm_scale + bias
        key_pos = start - pad + jnp.arange(BAND)
        s = jnp.where((key_pos >= 0)[None, None, None, :], s, NEG_INF)
        p = jax.nn.softmax(s, axis=-1)
        return jnp.einsum('bhqk,bkhd->bqhd', p.astype(vb.dtype), vb)

    out = lax.map(one_chunk, (jnp.arange(nc), q_chunks))
    return out.transpose(1, 0, 2, 3, 4).reshape(B, S, H, Dh)


def causal_depthwise_conv(u, w_conv, b_conv):
    ch = u.shape[-1]
    y = lax.conv_general_dilated(
        u, w_conv[:, None, :].astype(u.dtype), window_strides=(1,),
        padding=[(CONV_WIDTH - 1, 0)], dimension_numbers=('NWC', 'WIO', 'NWC'),
        feature_group_count=ch)
    return y + b_conv


def hybrid_mixer(h, w_in, q_norm_g, k_norm_g, rel_bias, w_conv, b_conv,
                 g_attn_out, g_conv_out, w_out):
    B, S, _ = h.shape
    proj = h @ w_in
    q, k, v, xc, gate_b, gate_c = jnp.split(
        proj, [D_ATTN, 2 * D_ATTN, 3 * D_ATTN, 3 * D_ATTN + D_CONV,
               3 * D_ATTN + 2 * D_CONV], axis=-1)
    q = rms_norm(q.reshape(B, S, N_HEADS, HEAD_DIM), q_norm_g)
    k = rms_norm(k.reshape(B, S, N_HEADS, HEAD_DIM), k_norm_g)
    v = v.reshape(B, S, N_HEADS, HEAD_DIM)
    y_attn = chunked_rel_attention(q, k, v, rel_bias).reshape(B, S, D_ATTN)
    y_conv = gate_b * causal_depthwise_conv(gate_c * xc, w_conv, b_conv)
    y = jnp.concatenate([rms_norm(y_attn, g_attn_out), rms_norm(y_conv, g_conv_out)], axis=-1)
    return y @ w_out


def setup_inputs(seed: int = 0) -> dict:
    key = jax.random.key(seed)
    ks = jax.random.split(key, 24)
    f32 = jnp.float32
    D, L = D_MODEL, DEPTH
    nrm = lambda k, shape, s: jax.random.normal(k, shape, f32) * s
    return {
        "x": nrm(ks[0], (BATCH, SEQ, D), 1.0),
        "c": nrm(ks[1], (BATCH, D), 1.0),
        "w_ada": nrm(ks[2], (L, D, N_SUB * 3 * D), 0.1 * D ** -0.5),
        "b_ada": nrm(ks[3], (L, N_SUB * 3 * D), 0.01),
        "g_norm": 1.0 + nrm(ks[4], (L, N_SUB, D), 0.02),
        "w_ffn1_in": nrm(ks[5], (L, D, 2 * D_FF), D ** -0.5),
        "w_ffn1_out": nrm(ks[6], (L, D_FF, D), D_FF ** -0.5),
        "w_in": nrm(ks[7], (L, D, 3 * D_ATTN + 3 * D_CONV), D ** -0.5),
        "q_norm_g": 1.0 + nrm(ks[8], (L, HEAD_DIM), 0.02),
        "k_norm_g": 1.0 + nrm(ks[9], (L, HEAD_DIM), 0.02),
        "rel_bias": nrm(ks[10], (L, N_HEADS, N_REL), 0.2),
        "w_conv": nrm(ks[11], (L, CONV_WIDTH, D_CONV), CONV_WIDTH ** -0.5),
        "b_conv": nrm(ks[12], (L, D_CONV), 0.01),
        "g_attn_out": 1.0 + nrm(ks[13], (L, D_ATTN), 0.02),
        "g_conv_out": 1.0 + nrm(ks[14], (L, D_CONV), 0.02),
        "w_out": nrm(ks[15], (L, D_MIX, D), D_MIX ** -0.5),
        "w_ffn2_in": nrm(ks[16], (L, D, 2 * D_FF), D ** -0.5),
        "w_ffn2_out": nrm(ks[17], (L, D_FF, D), D_FF ** -0.5),
        "g_final": 1.0 + nrm(ks[18], (L, D), 0.02),
    }


def reference(x, c, w_ada, b_ada, g_norm, w_ffn1_in, w_ffn1_out, w_in, q_norm_g,
              k_norm_g, rel_bias, w_conv, b_conv, g_attn_out, g_conv_out, w_out,
              w_ffn2_in, w_ffn2_out, g_final):
    B = x.shape[0]
    for l in range(DEPTH):
        mod = (jax.nn.silu(c) @ w_ada[l] + b_ada[l]).reshape(B, N_SUB, 3, D_MODEL)
        shift, scale, gate = mod[:, :, 0], mod[:, :, 1], mod[:, :, 2]
        h = adaln_pre(x, g_norm[l, 0], shift[:, 0], scale[:, 0])
        x = x + FFN_RES * (1.0 + gate[:, 0])[:, None, :] * swiglu(h, w_ffn1_in[l], w_ffn1_out[l])
        h = adaln_pre(x, g_norm[l, 1], shift[:, 1], scale[:, 1])
        y = hybrid_mixer(h, w_in[l], q_norm_g[l], k_norm_g[l], rel_bias[l], w_conv[l],
                         b_conv[l], g_attn_out[l], g_conv_out[l], w_out[l])
        x = x + (1.0 + gate[:, 1])[:, None, :] * y
        h = adaln_pre(x, g_norm[l, 2], shift[:, 2], scale[:, 2])
        x = x + FFN_RES * (1.0 + gate[:, 2])[:, None, :] * swiglu(h, w_ffn2_in[l], w_ffn2_out[l])
        x = rms_norm(x, g_final[l])
    return x
```

```cpp
#include <hip/hip_runtime.h>
#include <hip/hip_cooperative_groups.h>
#include <cstdio>
#include <cstdint>
namespace cg = cooperative_groups;
namespace pg8 {
#define PG8_LAS __attribute__((address_space(3)))
typedef unsigned short bf16_t;
typedef short bf16x8 __attribute__((ext_vector_type(8)));
typedef float f32x4 __attribute__((ext_vector_type(4)));
typedef unsigned u32x4 __attribute__((ext_vector_type(4)));
constexpr int BM = 256, BK = 64, HALF = 128, HTB = HALF * BK * 2  , STAGE_BYTES = 8 * HTB, NXCD = 8, WGM = 8;

__host__ __device__ __forceinline__ int lds_byte(int r, int c) { const int st = (r >> 4) * 2 + (c >> 5), rr = r & 15, cc = c & 31, ob = rr * 64 + cc * 2; return st * 1024 + (ob ^ (((ob >> 9) & 1) << 5)); }
__host__ __device__ __forceinline__ void stage_rc(int b, int& R, int& C) { const int st = b / 1024, sb = b % 1024, swz = sb ^ (((sb >> 9) & 1) << 5); R = (st >> 1) * 16 + swz / 64; C = (st & 1) * 32 + (swz % 64) / 2; }
__host__ __device__ __forceinline__ int perm32(int rho) { const int n = rho >> 4, i = rho & 15; return 8 * (i >> 2) + 4 * n + (i & 3); }

struct Unit { int pm, pn; };
struct Gemm { const bf16_t* A; const bf16_t* Bt; int M, N, K; };

struct StaticOrder {
    int nM, nN, nwg, G, c;
    __host__ __device__ void init(int M, int N, int G_, int c_) { nM = M / BM; nN = N / BM; nwg = nM * nN; G = G_; c = c_; }
    __host__ __device__ bool next(int i, Unit& u) const {
        const long L = (long)i * G + c; if (L >= nwg) return false;
        int wgid = (int)L; { const int q = nwg / NXCD, r = nwg % NXCD, xcd = wgid % NXCD, off = wgid / NXCD; wgid = (xcd < r ? xcd * (q + 1) : r * (q + 1) + (xcd - r) * q) + off; }
        const int nig = WGM * nN, gid = wgid / nig, fm = gid * WGM, gsz = (nM - fm) < WGM ? (nM - fm) : WGM;
        u.pm = fm + ((wgid % nig) % gsz); u.pn = (wgid % nig) / gsz; return true;
    }
    __device__ __forceinline__ void a_ready(const Unit&) const {}
    __device__ __forceinline__ void done(const Unit&) const {}
};


#define PG8_GAS __attribute__((address_space(1)))
typedef float f32x2 __attribute__((ext_vector_type(2)));
typedef __bf16 bf16x2_t __attribute__((ext_vector_type(2)));
__device__ __forceinline__ unsigned cvtpk(float lo, float hi) { f32x2 v = {lo, hi}; bf16x2_t b = __builtin_convertvector(v, bf16x2_t); return __builtin_bit_cast(unsigned, b); }
__device__ __forceinline__ float silu_mul(float g, float u) { return g * u * __builtin_amdgcn_rcpf(1.0f + __builtin_amdgcn_exp2f(-1.4426950408889634f * g)); }

struct EpiSwiglu {
    static constexpr bool PERM = true, AFTER_DRAIN = false, MIDK = false;
    bf16_t* O; int ldc;
    __device__ __forceinline__ void operator()(const f32x4 (&acc)[2][2][4][2], const Unit& u, int wr, int wc, int fr, int fq) const {
        const int row0 = u.pm * BM + wr * 64 + fr, col0 = u.pn * HALF + wc * 32 + 8 * fq;
#pragma unroll
        for (int ai = 0; ai < 2; ++ai)
#pragma unroll
            for (int m = 0; m < 4; ++m) {
                bf16_t* p = O + (size_t)(row0 + ai * HALF + m * 16) * ldc + col0;
                const f32x4 g0 = acc[ai][0][m][0], g1 = acc[ai][0][m][1], u0 = acc[ai][1][m][0], u1 = acc[ai][1][m][1];
                u32x4 w;
                w.x = cvtpk(silu_mul(g0[0], u0[0]), silu_mul(g0[1], u0[1])); w.y = cvtpk(silu_mul(g0[2], u0[2]), silu_mul(g0[3], u0[3]));
                w.z = cvtpk(silu_mul(g1[0], u1[0]), silu_mul(g1[1], u1[1])); w.w = cvtpk(silu_mul(g1[2], u1[2]), silu_mul(g1[3], u1[3]));
                *(PG8_GAS u32x4*)p = w;
            }
    }
};
struct EpiResid {
    static constexpr bool PERM = true, AFTER_DRAIN = false, MIDK = true;
    const float* xin; bf16_t* xs; const float* mod; const float* ssq; const float* gnext; bf16_t* xn; float* outf; float* xbuf; unsigned* cnt; PG8_LAS unsigned char* ldx; int step, midk;
    __device__ __forceinline__ void mid(f32x4 (&acc)[2][2][4][2], const Unit& u, int wr, int fr_in) const {
        int fr = fr_in; asm volatile("" : "+v"(fr));
#pragma unroll
        for (int ai = 0; ai < 2; ++ai)
#pragma unroll
            for (int m = 0; m < 4; ++m) {
                const float s = 1.0f / sqrtf(((const PG8_GAS float*)ssq)[u.pm * BM + ai * HALF + wr * 64 + m * 16 + fr] * (1.0f / 512.0f) + 1e-6f);
#pragma unroll
                for (int bj = 0; bj < 2; ++bj)
#pragma unroll
                    for (int n = 0; n < 2; ++n) acc[ai][bj][m][n] = acc[ai][bj][m][n] * s;
            }
    }
    __device__ __forceinline__ void operator()(f32x4 (&acc)[2][2][4][2], const Unit& u, int wr_in, int wc_in, int fr_in, int fq_in) const {
        int wr = wr_in, wc = wc_in, fr = fr_in, fq = fq_in; asm volatile("" : "+s"(wr), "+s"(wc), "+v"(fr), "+v"(fq));
        const int b = (u.pm * BM) >> 13;
        const float* gp = mod + b * 9216 + step * 3072 + 2048; const float coef = step == 1 ? 1.0f : 0.5f;
        const float* basef = step == 0 ? xin : (const float*)nullptr;
        const int col0 = u.pn * BM + wc * 32 + 8 * fq;
        PG8_LAS float* P = (PG8_LAS float*)ldx;
        PG8_LAS float* S = (PG8_LAS float*)(ldx + 4096);
        PG8_LAS unsigned* flag = (PG8_LAS unsigned*)(ldx + 5120);
        {
            f32x4 gv[2][2];
#pragma unroll
            for (int bj = 0; bj < 2; ++bj)
#pragma unroll
                for (int n = 0; n < 2; ++n) gv[bj][n] = (*(const PG8_GAS f32x4*)(gp + col0 + bj * HALF + 4 * n) + 1.0f) * coef;
#pragma unroll
            for (int ai = 0; ai < 2; ++ai)
#pragma unroll
                for (int m = 0; m < 4; ++m) {
                    const int rt = ai * HALF + wr * 64 + m * 16 + fr;
                    const size_t off = (size_t)(u.pm * BM + rt) * 1024 + col0;
                    float ss = 0.f;
#pragma unroll
                    for (int bj = 0; bj < 2; ++bj) {
                        f32x4 b0, b1;
                        if (basef) { b0 = *(const PG8_GAS f32x4*)(basef + off + bj * HALF); b1 = *(const PG8_GAS f32x4*)(basef + off + bj * HALF + 4); }
                        else { const u32x4 w = *(const PG8_GAS u32x4*)(xs + off + bj * HALF);
                            b0 = (f32x4){__uint_as_float(w.x << 16), __uint_as_float(w.x & 0xffff0000u), __uint_as_float(w.y << 16), __uint_as_float(w.y & 0xffff0000u)};
                            b1 = (f32x4){__uint_as_float(w.z << 16), __uint_as_float(w.z & 0xffff0000u), __uint_as_float(w.w << 16), __uint_as_float(w.w & 0xffff0000u)}; }
                        const f32x4 o0 = b0 + gv[bj][0] * acc[ai][bj][m][0], o1 = b1 + gv[bj][1] * acc[ai][bj][m][1];
                        acc[ai][bj][m][0] = o0; acc[ai][bj][m][1] = o1;
                        ss += ((o0[0] * o0[0] + o0[1] * o0[1]) + (o0[2] * o0[2] + o0[3] * o0[3])) + ((o1[0] * o1[0] + o1[1] * o1[1]) + (o1[2] * o1[2] + o1[3] * o1[3]));
                        if (step < 2) { u32x4 w; w.x = cvtpk(o0[0], o0[1]); w.y = cvtpk(o0[2], o0[3]); w.z = cvtpk(o1[0], o1[1]); w.w = cvtpk(o1[2], o1[3]);
                            *(PG8_GAS u32x4*)(xs + off + bj * HALF) = w; }
                    }
                    ss += __shfl_xor(ss, 16); ss += __shfl_xor(ss, 32);
                    if (fq == 0) P[rt * 4 + wc] = ss;
                }
        }
        asm volatile("s_waitcnt lgkmcnt(0)" ::: "memory"); __builtin_amdgcn_s_barrier(); asm volatile("" ::: "memory");
        const int wid = wr * 4 + wc, lane = fq * 16 + fr;
        if (wid < 4) {
            const int row = wid * 64 + lane;
            const f32x4 pv = *(const PG8_LAS f32x4*)(P + row * 4);
            __hip_atomic_store((PG8_GAS float*)xbuf + ((size_t)(u.pm * BM + row) * 4 + u.pn), (pv[0] + pv[1]) + (pv[2] + pv[3]), __ATOMIC_RELAXED, __HIP_MEMORY_SCOPE_AGENT);
            asm volatile("s_waitcnt vmcnt(0)" ::: "memory");
            if (lane == 0) (void)__hip_atomic_fetch_add((PG8_GAS unsigned*)cnt + u.pm, 1u, __ATOMIC_RELAXED, __HIP_MEMORY_SCOPE_AGENT);
        }
        if (wid == 0) {
            unsigned spins = 0;
            while ((unsigned)__builtin_amdgcn_readfirstlane((int)__hip_atomic_load((PG8_GAS unsigned*)cnt + u.pm, __ATOMIC_RELAXED, __HIP_MEMORY_SCOPE_AGENT)) < 16u) {
                __builtin_amdgcn_s_sleep(2); if (++spins > (1u << 18)) break; }
            __builtin_amdgcn_fence(__ATOMIC_ACQUIRE, "agent");
            if (lane == 0) flag[0] = 1u;
        }
        asm volatile("s_waitcnt vmcnt(0) lgkmcnt(0)" ::: "memory"); __builtin_amdgcn_s_barrier(); asm volatile("" ::: "memory");
        if (wid < 4) {
            const int row = wid * 64 + lane;
            const PG8_GAS float* sl = (const PG8_GAS float*)xbuf + (size_t)(u.pm * BM + row) * 4;
            const float t0 = __hip_atomic_load(sl, __ATOMIC_RELAXED, __HIP_MEMORY_SCOPE_AGENT), t1 = __hip_atomic_load(sl + 1, __ATOMIC_RELAXED, __HIP_MEMORY_SCOPE_AGENT),
                        t2 = __hip_atomic_load(sl + 2, __ATOMIC_RELAXED, __HIP_MEMORY_SCOPE_AGENT), t3 = __hip_atomic_load(sl + 3, __ATOMIC_RELAXED, __HIP_MEMORY_SCOPE_AGENT);
            S[row] = 1.0f / sqrtf(((t0 + t1) + (t2 + t3)) * (1.0f / 1024.0f) + 1e-6f);
        }
        asm volatile("s_waitcnt vmcnt(0) lgkmcnt(0)" ::: "memory"); __builtin_amdgcn_s_barrier(); asm volatile("" ::: "memory");
        if (step < 2) {
            const float* mb = mod + b * 9216 + (step + 1) * 3072;
#pragma unroll
            for (int bj = 0; bj < 2; ++bj) {
                const int c = col0 + bj * HALF;
                const f32x4 g0 = *(const PG8_GAS f32x4*)(gnext + c) * (*(const PG8_GAS f32x4*)(mb + 1024 + c) + 1.0f), g1 = *(const PG8_GAS f32x4*)(gnext + c + 4) * (*(const PG8_GAS f32x4*)(mb + 1024 + c + 4) + 1.0f);
                const f32x4 h0 = *(const PG8_GAS f32x4*)(mb + c), h1 = *(const PG8_GAS f32x4*)(mb + c + 4);
#pragma unroll
                for (int ai = 0; ai < 2; ++ai)
#pragma unroll
                    for (int m = 0; m < 4; ++m) {
                        const int rt = ai * HALF + wr * 64 + m * 16 + fr; const float rs = S[rt];
                        const f32x4 y0 = acc[ai][bj][m][0] * rs * g0 + h0, y1 = acc[ai][bj][m][1] * rs * g1 + h1;
                        u32x4 w; w.x = cvtpk(y0[0], y0[1]); w.y = cvtpk(y0[2], y0[3]); w.z = cvtpk(y1[0], y1[1]); w.w = cvtpk(y1[2], y1[3]);
                        *(PG8_GAS u32x4*)(xn + (size_t)(u.pm * BM + rt) * 1024 + c) = w;
                    }
            }
        } else {
#pragma unroll
            for (int bj = 0; bj < 2; ++bj) {
                const int c = col0 + bj * HALF;
                const f32x4 g0 = *(const PG8_GAS f32x4*)(gnext + c), g1 = *(const PG8_GAS f32x4*)(gnext + c + 4);
#pragma unroll
                for (int ai = 0; ai < 2; ++ai)
#pragma unroll
                    for (int m = 0; m < 4; ++m) {
                        const int rt = ai * HALF + wr * 64 + m * 16 + fr; const float rs = S[rt];
                        PG8_GAS f32x4* op = (PG8_GAS f32x4*)(outf + (size_t)(u.pm * BM + rt) * 1024 + c);
                        op[0] = acc[ai][bj][m][0] * rs * g0; op[1] = acc[ai][bj][m][1] * rs * g1;
                    }
            }
        }
        asm volatile("s_waitcnt lgkmcnt(0)" ::: "memory"); __builtin_amdgcn_s_barrier(); asm volatile("" ::: "memory");
    }
};
struct EpiProj {
    static constexpr bool PERM = true, AFTER_DRAIN = false, MIDK = false;
    bf16_t* O; const float* gq; const float* gk;
    __device__ __forceinline__ void operator()(const f32x4 (&acc)[2][2][4][2], const Unit& u, int wr, int wc, int fr, int fq) const {
        const int row0 = u.pm * BM + wr * 64 + fr, colh = u.pn * BM + wc * 64 + 8 * fq;
        if (u.pn < 4) {
            const float* g = (u.pn < 2) ? gq : gk; const float sc = (u.pn < 2) ? 0.125f * 1.4426950408889634f : 1.0f;
            f32x4 gv[2][2];
#pragma unroll
            for (int bj = 0; bj < 2; ++bj)
#pragma unroll
                for (int n = 0; n < 2; ++n) gv[bj][n] = *(const PG8_GAS f32x4*)(g + 32 * bj + 8 * fq + 4 * n) * sc;
#pragma unroll
            for (int ai = 0; ai < 2; ++ai)
#pragma unroll
                for (int m = 0; m < 4; ++m) {
                    float ss = 0.f;
#pragma unroll
                    for (int bj = 0; bj < 2; ++bj)
#pragma unroll
                        for (int n = 0; n < 2; ++n) { const f32x4 x = acc[ai][bj][m][n]; ss += (x[0] * x[0] + x[1] * x[1]) + (x[2] * x[2] + x[3] * x[3]); }
                    ss += __shfl_xor(ss, 16); ss += __shfl_xor(ss, 32);
                    const float rstd = 1.0f / sqrtf(ss * (1.0f / 64.0f) + 1e-6f);
                    bf16_t* p = O + (size_t)(row0 + ai * HALF + m * 16) * 3072 + colh;
#pragma unroll
                    for (int bj = 0; bj < 2; ++bj) {
                        const f32x4 v0 = acc[ai][bj][m][0] * rstd * gv[bj][0], v1 = acc[ai][bj][m][1] * rstd * gv[bj][1];
                        u32x4 w; w.x = cvtpk(v0[0], v0[1]); w.y = cvtpk(v0[2], v0[3]); w.z = cvtpk(v1[0], v1[1]); w.w = cvtpk(v1[2], v1[3]);
                        *(PG8_GAS u32x4*)(p + 32 * bj) = w;
                    }
                }
        } else {
#pragma unroll
            for (int ai = 0; ai < 2; ++ai)
#pragma unroll
                for (int m = 0; m < 4; ++m) {
                    bf16_t* p = O + (size_t)(row0 + ai * HALF + m * 16) * 3072 + colh;
#pragma unroll
                    for (int bj = 0; bj < 2; ++bj) {
                        const f32x4 v0 = acc[ai][bj][m][0], v1 = acc[ai][bj][m][1];
                        u32x4 w; w.x = cvtpk(v0[0], v0[1]); w.y = cvtpk(v0[2], v0[3]); w.z = cvtpk(v1[0], v1[1]); w.w = cvtpk(v1[2], v1[3]);
                        *(PG8_GAS u32x4*)(p + 32 * bj) = w;
                    }
                }
        }
    }
};

template <class Epi, class Sched, bool ALIGN_EPI = false, bool SP2 = false>
__device__ __forceinline__ void gemm_phase(PG8_LAS unsigned char* lds, const Gemm g, const Sched& S, const Epi& E, const int tid) {
    const int  wid = __builtin_amdgcn_readfirstlane(tid >> 6), lane = tid & 63, wr = wid >> 2, wc = wid & 3, fr = lane & 15, fq = lane >> 4;
    const int K = g.K, nt = K / BK;
    unsigned voffA[2], voffB[2];
#pragma unroll
    for (int i = 0; i < 2; ++i) { int R, C; stage_rc(tid * 16 + i * 8192, R, C); const int Rb = Epi::PERM ? ((R & ~31) + perm32(R & 31)) : R;
        voffA[i] = (unsigned)(R * K + C) * 2u; voffB[i] = (unsigned)(Rb * K + C) * 2u; }
    const size_t kstep = (size_t)(BK * 2);
    const size_t hstep = (size_t)HALF * K * 2;
    const size_t tstep = 2 * hstep;
    const unsigned ldsw = (unsigned)wid * 1024u;
    const int aoff = lds_byte(wr * 64 + fr, fq * 8), boff = lds_byte(wc * 32 + fr, fq * 8);
#define PG8_SA(b, h) (((b) * 2 + (h)) * HTB)
#define PG8_SB(b, h) ((4 + (b) * 2 + (h)) * HTB)
#define PG8_STAGE(bufoff, gbase, voff) do { _Pragma("unroll") for (int _i = 0; _i < 2; ++_i) \
        __builtin_amdgcn_global_load_lds((const unsigned*)((const char*)(gbase) + (voff)[_i]), (PG8_LAS unsigned*)(lds + (bufoff) + ldsw + _i * 8192), 16, 0, 0); } while (0)
#define PG8_LDA(dst, b, h) do { _Pragma("unroll") for (int m = 0; m < 4; ++m) _Pragma("unroll") for (int k = 0; k < 2; ++k) dst[m][k] = *(const PG8_LAS bf16x8*)(lds + PG8_SA(b, h) + aoff + m * 2048 + k * 1024); } while (0)
#define PG8_LDB(dst, b, h) do { _Pragma("unroll") for (int n = 0; n < 2; ++n) _Pragma("unroll") for (int k = 0; k < 2; ++k) dst[n][k] = *(const PG8_LAS bf16x8*)(lds + PG8_SB(b, h) + boff + n * 2048 + k * 1024); } while (0)
#define PG8_MMA(ai, bj, At, Bt) do { __builtin_amdgcn_s_setprio(1); _Pragma("unroll") for (int m = 0; m < 4; ++m) _Pragma("unroll") for (int n = 0; n < 2; ++n) _Pragma("unroll") for (int k = 0; k < 2; ++k) \
        acc[ai][bj][m][n] = __builtin_amdgcn_mfma_f32_16x16x32_bf16(Bt[n][k], At[m][k], acc[ai][bj][m][n], 0, 0, 0); __builtin_amdgcn_s_setprio(0); } while (0)
#define PG8_WAIT_V(n) asm volatile("s_waitcnt vmcnt(" #n ")" ::: "memory")
#define PG8_WAIT_L(n) asm volatile("s_waitcnt lgkmcnt(" #n ")" ::: "memory")
#define PG8_BAR __builtin_amdgcn_s_barrier()
#define PG8_SCHED __builtin_amdgcn_sched_barrier(0)
    Unit cur, nxt; int ui = 0;
    if (!S.next(0, cur)) return;
    f32x4 acc[2][2][4][2];
#pragma unroll
    for (int a = 0; a < 2; ++a)
#pragma unroll
        for (int b = 0; b < 2; ++b)
#pragma unroll
            for (int m = 0; m < 4; ++m)
#pragma unroll
                for (int n = 0; n < 2; ++n) acc[a][b][m][n] = (f32x4){0.f, 0.f, 0.f, 0.f};
    bf16x8 At[4][2], B0[2][2], B1[2][2];
    const char* cA = (const char*)g.A + (size_t)cur.pm * tstep; const char* cB = (const char*)g.Bt + (size_t)cur.pn * tstep;
    S.a_ready(cur);
    if constexpr (SP2) {
        PG8_STAGE(PG8_SB(0, 0), cB, voffB); PG8_STAGE(PG8_SB(0, 1), cB + hstep, voffB); PG8_STAGE(PG8_SA(0, 0), cA, voffA); PG8_STAGE(PG8_SA(0, 1), cA + hstep, voffA);
        if (wr == 1) PG8_BAR;
        PG8_WAIT_V(2); PG8_BAR;
        PG8_STAGE(PG8_SB(1, 0), cB + kstep, voffB); PG8_STAGE(PG8_SA(1, 0), cA + kstep, voffA); PG8_STAGE(PG8_SB(1, 1), cB + hstep + kstep, voffB);
        PG8_WAIT_V(6); PG8_BAR;
    } else {
        PG8_STAGE(PG8_SB(0, 0), cB, voffB); PG8_STAGE(PG8_SA(0, 0), cA, voffA); PG8_STAGE(PG8_SB(0, 1), cB + hstep, voffB); PG8_STAGE(PG8_SA(0, 1), cA + hstep, voffA);
        if (wr == 1) PG8_BAR;
        PG8_WAIT_V(4); PG8_BAR;
        PG8_STAGE(PG8_SB(1, 0), cB + kstep, voffB); PG8_STAGE(PG8_SA(1, 0), cA + kstep, voffA); PG8_STAGE(PG8_SB(1, 1), cB + hstep + kstep, voffB);
        PG8_WAIT_V(6); PG8_BAR;
    }
    for (;;) {
        const bool has_next = S.next(ui + 1, nxt);
        const char* nA = has_next ? (const char*)g.A + (size_t)nxt.pm * tstep : cA; const char* nB = has_next ? (const char*)g.Bt + (size_t)nxt.pn * tstep : cB;
        for (int t = 0; t < nt; t += 2) {
            if constexpr (Epi::MIDK) { if (t == E.midk) E.mid(acc, cur, wr, fr); }
            const bool last = (t == nt - 2);
            const char* a1 = cA + (size_t)(t + 1) * kstep;
            const char* a2 = last ? nA : cA + (size_t)(t + 2) * kstep; const char* b2 = last ? nB : cB + (size_t)(t + 2) * kstep;
            const char* a3 = a2 + kstep; const char* b3 = b2 + kstep;
            if (last && has_next) S.a_ready(nxt);
            if constexpr (SP2) {
            PG8_LDB(B0, 0, 0); PG8_LDB(B1, 0, 1); PG8_SCHED; PG8_LDA(At, 0, 0); PG8_STAGE(PG8_SA(1, 1), a1 + hstep, voffA);
            PG8_WAIT_V(8); PG8_WAIT_L(0); PG8_BAR; PG8_MMA(0, 0, At, B0); PG8_MMA(0, 1, At, B1); PG8_BAR; PG8_SCHED;
            PG8_LDA(At, 0, 1); PG8_STAGE(PG8_SB(0, 0), b2, voffB); PG8_STAGE(PG8_SB(0, 1), b2 + hstep, voffB); PG8_STAGE(PG8_SA(0, 0), a2, voffA);
            PG8_WAIT_V(8); PG8_WAIT_L(0); PG8_BAR; PG8_MMA(1, 0, At, B0); PG8_MMA(1, 1, At, B1); PG8_BAR; PG8_SCHED;
            PG8_LDB(B0, 1, 0); PG8_LDB(B1, 1, 1); PG8_SCHED; PG8_LDA(At, 1, 0); PG8_STAGE(PG8_SA(0, 1), a2 + hstep, voffA);
            PG8_WAIT_V(8); PG8_WAIT_L(0); PG8_BAR; PG8_MMA(0, 0, At, B0); PG8_MMA(0, 1, At, B1); PG8_BAR; PG8_SCHED;
            PG8_LDA(At, 1, 1); PG8_STAGE(PG8_SB(1, 0), b3, voffB); PG8_STAGE(PG8_SB(1, 1), b3 + hstep, voffB); PG8_STAGE(PG8_SA(1, 0), a3, voffA);
            PG8_WAIT_V(8); PG8_WAIT_L(0); PG8_BAR; PG8_MMA(1, 0, At, B0); PG8_MMA(1, 1, At, B1); PG8_BAR; PG8_SCHED;
            } else {
            PG8_LDB(B0, 0, 0); PG8_SCHED; PG8_LDA(At, 0, 0); PG8_STAGE(PG8_SA(1, 1), a1 + hstep, voffA);
            PG8_WAIT_L(8); PG8_BAR; PG8_WAIT_L(0); PG8_MMA(0, 0, At, B0); PG8_BAR; PG8_SCHED;
            PG8_LDB(B1, 0, 1); PG8_STAGE(PG8_SB(0, 0), b2, voffB);
            PG8_BAR; PG8_WAIT_L(0); PG8_MMA(0, 1, At, B1); PG8_BAR;
            PG8_LDA(At, 0, 1); PG8_STAGE(PG8_SA(0, 0), a2, voffA);
            PG8_BAR; PG8_WAIT_L(0); PG8_MMA(1, 0, At, B0); PG8_BAR; PG8_SCHED;
            PG8_STAGE(PG8_SB(0, 1), b2 + hstep, voffB);
            PG8_WAIT_V(6); PG8_BAR; PG8_MMA(1, 1, At, B1); PG8_BAR;
            PG8_LDB(B0, 1, 0); PG8_SCHED; PG8_LDA(At, 1, 0); PG8_STAGE(PG8_SA(0, 1), a2 + hstep, voffA);
            PG8_WAIT_L(8); PG8_BAR; PG8_WAIT_L(0); PG8_MMA(0, 0, At, B0); PG8_BAR; PG8_SCHED;
            PG8_LDB(B1, 1, 1); PG8_STAGE(PG8_SB(1, 0), b3, voffB);
            PG8_BAR; PG8_WAIT_L(0); PG8_MMA(0, 1, At, B1); PG8_BAR;
            PG8_LDA(At, 1, 1); PG8_STAGE(PG8_SA(1, 0), a3, voffA);
            PG8_BAR; PG8_WAIT_L(0); PG8_MMA(1, 0, At, B0); PG8_BAR; PG8_SCHED;
            PG8_STAGE(PG8_SB(1, 1), b3 + hstep, voffB);
            PG8_WAIT_V(6); PG8_BAR; PG8_MMA(1, 1, At, B1); PG8_BAR;
            }
        }
        if constexpr (ALIGN_EPI) { if (wr == 0) PG8_BAR; }
        if constexpr (!Epi::AFTER_DRAIN) { E(acc, cur, wr, wc, fr, fq); S.done(cur); }
        if (!has_next) break;
#pragma unroll
        for (int a = 0; a < 2; ++a)
#pragma unroll
            for (int b = 0; b < 2; ++b)
#pragma unroll
                for (int m = 0; m < 4; ++m)
#pragma unroll
                    for (int n = 0; n < 2; ++n) acc[a][b][m][n] = (f32x4){0.f, 0.f, 0.f, 0.f};
        cur = nxt; cA = nA; cB = nB; ++ui;
        if constexpr (ALIGN_EPI) { if (wr == 1) PG8_BAR; }
    }
    PG8_WAIT_V(0);
    if constexpr (!ALIGN_EPI) { if (wr == 0) PG8_BAR; }
    PG8_BAR;
    if constexpr (Epi::AFTER_DRAIN) { E.fused(acc, cur, wr, wc, fr, fq, lds, wid, lane); S.done(cur); }
#undef PG8_SA
#undef PG8_SB
#undef PG8_STAGE
#undef PG8_LDA
#undef PG8_LDB
#undef PG8_MMA
#undef PG8_WAIT_V
#undef PG8_WAIT_L
#undef PG8_BAR
#undef PG8_SCHED
}
}

#define LAS __attribute__((address_space(3)))
typedef unsigned short bf16;
typedef float f32x4 __attribute__((ext_vector_type(4)));
typedef short bf16x8 __attribute__((ext_vector_type(8)));
typedef unsigned u32x4 __attribute__((ext_vector_type(4)));
typedef unsigned u32x2 __attribute__((ext_vector_type(2)));
using pg8::cvtpk;

#ifndef KN_NORM
#define KN_NORM 1
#endif
#ifndef KN_UP
#define KN_UP 1
#endif
#ifndef KN_PROJ
#define KN_PROJ 1
#endif
#ifndef KN_ATT
#define KN_ATT 1
#endif
#ifndef KN_CONV
#define KN_CONV 1
#endif
#ifndef KN_RES0
#define KN_RES0 1
#endif
#ifndef KN_SYNC
#define KN_SYNC 0
#endif
constexpr int NWAVES = 8;
constexpr int BATCH = 8, SEQ = 8192, D = 1024, DFF = 2816, NPROJ = 3072, M = BATCH * SEQ;
constexpr int NMOD = 9216;
constexpr float EPS = 1e-6f;
constexpr float L2E = 1.4426950408889634f;
constexpr int LDS_BYTES = 147456;

constexpr size_t MiB = 1u << 20;
constexpr size_t WS_MOD = 0;
constexpr size_t MOD_BYTES = (size_t)BATCH * NMOD * 4;
constexpr size_t WS_BAR = 512 * 1024;
constexpr size_t WS_SSQ = 576 * 1024;
constexpr size_t WS_CNT = 960 * 1024;
constexpr size_t CTL_ZERO_BYTES = 1 * MiB;
constexpr size_t WS_W1IN = 2 * MiB, WS_W1OUT = 13 * MiB, WS_WIN = 19 * MiB, WS_WOUT = 25 * MiB, WS_W2IN = 27 * MiB, WS_W2OUT = 38 * MiB;
constexpr size_t WS_XN = 64 * MiB;
constexpr size_t WS_ACT = 192 * MiB;
constexpr size_t WS_XS = 576 * MiB;
constexpr size_t WS_XN2 = 704 * MiB;
constexpr size_t WS_XBUF = 832 * MiB;
constexpr size_t WS_END = 835 * MiB;

__device__ __forceinline__ int fresh_lane() { int z = 0; asm volatile("" : "+v"(z)); return (int)__builtin_amdgcn_mbcnt_hi(~0u, __builtin_amdgcn_mbcnt_lo(~0u, (unsigned)z)); }
__device__ __forceinline__ int launder_s(int v) { asm volatile("" : "+s"(v)); return v; }
__device__ __forceinline__ int launder_v(int v) { asm volatile("" : "+v"(v)); return v; }
__device__ __forceinline__ int opaque_zero() { int z = 0; asm volatile("" : "+s"(z)); return z; }
template <class T> __device__ __forceinline__ T* launder(T* p) { asm volatile("" : "+s"(p)); return p; }
#define GAS __attribute__((address_space(1)))
template <class T> __device__ __forceinline__ GAS T* gp(T* p) { return (GAS T*)p; }
__device__ __forceinline__ float wave_sum(float v) {
#pragma unroll
    for (int o = 1; o < 64; o <<= 1) v += __shfl_xor(v, o);
    return v;
}
__device__ __forceinline__ float wave_max(float v) {
#pragma unroll
    for (int o = 1; o < 64; o <<= 1) v = fmaxf(v, __shfl_xor(v, o));
    return v;
}
__device__ __forceinline__ float bf_lo(unsigned w) { return __uint_as_float(w << 16); }
__device__ __forceinline__ float bf_hi(unsigned w) { return __uint_as_float(w & 0xffff0000u); }

__device__ __forceinline__ void transpose_item(const float* W, int K, int N, bf16* WT, int k0, int n0, int drow0, LAS float* scr, int lane, const float* kscale = nullptr) {
    {
        f32x4 w[8]; const int c4 = lane & 7, r8 = lane >> 3;
#pragma unroll
        for (int i = 0; i < 8; ++i) w[i] = *(const GAS f32x4*)(W + (size_t)(k0 + 8 * i + r8) * N + n0 + 4 * c4);
#pragma unroll
        for (int i = 0; i < 8; ++i) { const int kk = 8 * i + r8; f32x4 v = w[i]; if (kscale) v = v * ((const GAS float*)kscale)[k0 + kk];
            LAS float* d = scr + kk * 33 + 4 * c4; d[0] = v[0]; d[1] = v[1]; d[2] = v[2]; d[3] = v[3]; }
    }
    asm volatile("s_waitcnt lgkmcnt(0)" ::: "memory");
    const int c = lane & 7;
#pragma unroll
    for (int j = 0; j < 4; ++j) { const int n = (lane >> 3) + 8 * j; const LAS float* s = scr + (8 * c) * 33 + n;
        u32x4 o; o.x = cvtpk(s[0 * 33], s[1 * 33]); o.y = cvtpk(s[2 * 33], s[3 * 33]); o.z = cvtpk(s[4 * 33], s[5 * 33]); o.w = cvtpk(s[6 * 33], s[7 * 33]);
        *(GAS u32x4*)(WT + (size_t)(drow0 + n) * K + k0 + 8 * c) = o; }
    asm volatile("s_waitcnt lgkmcnt(0)" ::: "memory");
}
__device__ __forceinline__ int drow_plain(int n0) { return n0; }
__device__ __forceinline__ int drow_swiglu(int n0) { return n0 < DFF ? (n0 >> 7) * 256 + (n0 & 127) : ((n0 - DFF) >> 7) * 256 + 128 + ((n0 - DFF) & 127); }
__device__ __forceinline__ int drow_proj(int n0) { const int L = n0 & 255; return (n0 & ~255) + 128 * ((L >> 5) & 1) + 32 * (L >> 6); }

template <int R> __device__ __forceinline__ void norm_rows_bf16(const float* x, bf16* o, int m0, int rstride, const float* g, const float* shift, const float* scale, int lane) {
    f32x4 v[R][4]; float s[R];
#pragma unroll
    for (int r = 0; r < R; ++r) { const GAS f32x4* xr = (const GAS f32x4*)(x + (size_t)(m0 + r * rstride) * D) + lane;
#pragma unroll
        for (int j = 0; j < 4; ++j) v[r][j] = xr[64 * j]; }
#pragma unroll
    for (int r = 0; r < R; ++r) { s[r] = 0.f;
#pragma unroll
        for (int j = 0; j < 4; ++j) s[r] += (v[r][j].x * v[r][j].x + v[r][j].y * v[r][j].y) + (v[r][j].z * v[r][j].z + v[r][j].w * v[r][j].w); }
#pragma unroll
    for (int of = 1; of < 64; of <<= 1) {
#pragma unroll
        for (int r = 0; r < R; ++r) s[r] += __shfl_xor(s[r], of); }
#pragma unroll
    for (int j = 0; j < 4; ++j) {
        const f32x4 gg = ((const GAS f32x4*)g)[lane + 64 * j], sh = ((const GAS f32x4*)shift)[lane + 64 * j], sc = ((const GAS f32x4*)scale)[lane + 64 * j];
        const f32x4 gs = gg * (sc + 1.0f);
#pragma unroll
        for (int r = 0; r < R; ++r) {
            const float rstd = 1.0f / sqrtf(s[r] * (1.0f / D) + EPS);
            const f32x4 y = v[r][j] * rstd * gs + sh;
            u32x2 w; w.x = cvtpk(y.x, y.y); w.y = cvtpk(y.z, y.w); ((GAS u32x2*)(o + (size_t)(m0 + r * rstride) * D) + lane)[64 * j] = w;
        }
    }
}
template <int R> __device__ __forceinline__ void final_norm_rows(float* x, int m0, int rstride, const float* g, int lane) {
    f32x4 v[R][4]; float s[R];
#pragma unroll
    for (int r = 0; r < R; ++r) { const GAS f32x4* xr = (const GAS f32x4*)(x + (size_t)(m0 + r * rstride) * D) + lane;
#pragma unroll
        for (int j = 0; j < 4; ++j) v[r][j] = xr[64 * j]; }
#pragma unroll
    for (int r = 0; r < R; ++r) { s[r] = 0.f;
#pragma unroll
        for (int j = 0; j < 4; ++j) s[r] += (v[r][j].x * v[r][j].x + v[r][j].y * v[r][j].y) + (v[r][j].z * v[r][j].z + v[r][j].w * v[r][j].w); }
#pragma unroll
    for (int of = 1; of < 64; of <<= 1) {
#pragma unroll
        for (int r = 0; r < R; ++r) s[r] += __shfl_xor(s[r], of); }
#pragma unroll
    for (int j = 0; j < 4; ++j) {
        const f32x4 gg = ((const GAS f32x4*)g)[lane + 64 * j];
#pragma unroll
        for (int r = 0; r < R; ++r) {
            const float rstd = 1.0f / sqrtf(s[r] * (1.0f / D) + EPS);
            ((GAS f32x4*)(x + (size_t)(m0 + r * rstride) * D) + lane)[64 * j] = v[r][j] * rstd * gg;
        }
    }
}

__device__ __forceinline__ f32x4 unpack_lo4(const u32x4 w) { return (f32x4){bf_lo(w.x), bf_hi(w.x), bf_lo(w.y), bf_hi(w.y)}; }
__device__ __forceinline__ f32x4 unpack_hi4(const u32x4 w) { return (f32x4){bf_lo(w.z), bf_hi(w.z), bf_lo(w.w), bf_hi(w.w)}; }
__device__ __forceinline__ float sumsq8(const u32x4 w) { const f32x4 a = unpack_lo4(w), b = unpack_hi4(w); return ((a.x * a.x + a.y * a.y) + (a.z * a.z + a.w * a.w)) + ((b.x * b.x + b.y * b.y) + (b.z * b.z + b.w * b.w)); }
template <int R> __device__ __forceinline__ void norm_rows_bf16in(const bf16* x, bf16* o, int m0, int rstride, const float* g, const float* shift, const float* scale, int lane) {
    u32x4 v[R][2]; float s[R];
#pragma unroll
    for (int r = 0; r < R; ++r) { const GAS u32x4* xr = (const GAS u32x4*)(x + (size_t)(m0 + r * rstride) * D) + lane; v[r][0] = xr[0]; v[r][1] = xr[64]; }
#pragma unroll
    for (int r = 0; r < R; ++r) { s[r] = 0.f;
#pragma unroll
        for (int j = 0; j < 2; ++j) s[r] += sumsq8(v[r][j]); }
#pragma unroll
    for (int of = 1; of < 64; of <<= 1) {
#pragma unroll
        for (int r = 0; r < R; ++r) s[r] += __shfl_xor(s[r], of); }
#pragma unroll
    for (int j = 0; j < 2; ++j) {
        const int i4 = 2 * (lane + 64 * j);
        const f32x4 g0 = ((const GAS f32x4*)g)[i4], g1 = ((const GAS f32x4*)g)[i4 + 1], h0 = ((const GAS f32x4*)shift)[i4], h1 = ((const GAS f32x4*)shift)[i4 + 1], c0 = ((const GAS f32x4*)scale)[i4], c1 = ((const GAS f32x4*)scale)[i4 + 1];
        const f32x4 gs0 = g0 * (c0 + 1.0f), gs1 = g1 * (c1 + 1.0f);
#pragma unroll
        for (int r = 0; r < R; ++r) {
            const float rstd = 1.0f / sqrtf(s[r] * (1.0f / D) + EPS);
            const f32x4 y0 = unpack_lo4(v[r][j]) * rstd * gs0 + h0, y1 = unpack_hi4(v[r][j]) * rstd * gs1 + h1;
            u32x4 w; w.x = cvtpk(y0.x, y0.y); w.y = cvtpk(y0.z, y0.w); w.z = cvtpk(y1.x, y1.y); w.w = cvtpk(y1.z, y1.w);
            ((GAS u32x4*)(o + (size_t)(m0 + r * rstride) * D) + lane)[64 * j] = w;
        }
    }
}
template <int R> __device__ __forceinline__ void final_norm_rows_bf16in(const bf16* x, float* o, int m0, int rstride, const float* g, int lane) {
    u32x4 v[R][2]; float s[R];
#pragma unroll
    for (int r = 0; r < R; ++r) { const GAS u32x4* xr = (const GAS u32x4*)(x + (size_t)(m0 + r * rstride) * D) + lane; v[r][0] = xr[0]; v[r][1] = xr[64]; }
#pragma unroll
    for (int r = 0; r < R; ++r) { s[r] = 0.f;
#pragma unroll
        for (int j = 0; j < 2; ++j) s[r] += sumsq8(v[r][j]); }
#pragma unroll
    for (int of = 1; of < 64; of <<= 1) {
#pragma unroll
        for (int r = 0; r < R; ++r) s[r] += __shfl_xor(s[r], of); }
#pragma unroll
    for (int j = 0; j < 2; ++j) {
        const int i4 = 2 * (lane + 64 * j);
        const f32x4 g0 = ((const GAS f32x4*)g)[i4], g1 = ((const GAS f32x4*)g)[i4 + 1];
#pragma unroll
        for (int r = 0; r < R; ++r) {
            const float rstd = 1.0f / sqrtf(s[r] * (1.0f / D) + EPS);
            GAS f32x4* op = (GAS f32x4*)(o + (size_t)(m0 + r * rstride) * D) + i4;
            op[0] = unpack_lo4(v[r][j]) * rstd * g0; op[1] = unpack_hi4(v[r][j]) * rstd * g1;
        }
    }
}

__device__ __forceinline__ void mod_item(const float* c, const float* w_ada, const float* b_ada, float* mod, int item, int lane) {
    const int ks = item / 36, nb = item % 36, k0 = ks * 64, n0 = nb * 256 + 4 * lane;
    float sv[BATCH];
#pragma unroll
    for (int b = 0; b < BATCH; ++b) { const float x = c[b * D + k0 + lane]; sv[b] = x * __builtin_amdgcn_rcpf(1.0f + __builtin_amdgcn_exp2f(-L2E * x)); }
    f32x4 acc[BATCH];
#pragma unroll
    for (int b = 0; b < BATCH; ++b) acc[b] = (f32x4){0.f, 0.f, 0.f, 0.f};
    const float* wp = w_ada + (size_t)k0 * NMOD + n0;
#pragma unroll 8
    for (int kk = 0; kk < 64; ++kk) {
        const f32x4 w = *(const f32x4*)(wp + (size_t)kk * NMOD);
#pragma unroll
        for (int b = 0; b < BATCH; ++b) { const float s = __builtin_bit_cast(float, __builtin_amdgcn_readlane(__builtin_bit_cast(int, sv[b]), kk)); acc[b] += w * s; }
    }
    if (ks == 0) { const f32x4 bb = *(const f32x4*)(b_ada + n0);
#pragma unroll
        for (int b = 0; b < BATCH; ++b) acc[b] += bb; }
#pragma unroll
    for (int b = 0; b < BATCH; ++b) { float* mp = mod + b * NMOD + n0; atomicAdd(mp, acc[b].x); atomicAdd(mp + 1, acc[b].y); atomicAdd(mp + 2, acc[b].z); atomicAdd(mp + 3, acc[b].w); }
}

constexpr int KP = 144;
constexpr int AT_TILE = 64 * KP, AT_STAGE = 4 * AT_TILE;
constexpr int AT_TB = 2 * AT_STAGE;
static_assert(AT_TB + 257 * 4 <= 131072, "attention LDS map");

__device__ __forceinline__ void attn_bias_table(LAS unsigned char* lds, const float* relb, const float* gqn, const float* gkn, int h, int lane, int tid) {
    LAS float* tb = (LAS float*)(lds + AT_TB);
    {
        const float mq = wave_max(fabsf(gp(gqn)[lane])), mk = wave_max(fabsf(gp(gkn)[lane]));
        float bm = -3.0e38f;
#pragma unroll
        for (int j = 0; j < 5; ++j) { const int idx = lane + 64 * j; bm = fmaxf(bm, idx < 257 ? gp(relb)[h * 257 + idx] : -3.0e38f); }
        bm = wave_max(bm);
        const float B = L2E * (8.1f * mq * mk + bm);
        if (tid < 257) tb[tid] = L2E * gp(relb)[h * 257 + tid] - B;
    }
}
__device__ __forceinline__ void attn_unit(LAS unsigned char* lds, const bf16* PROJ, bf16* YMIX, float* ssq, const float* relb, const float* gqn, const float* gkn,
                                          int b, int h, int c0, int wave, int lane_in, int tid_in) {
    const int lane = launder_v(lane_in), tid = launder_v(tid_in); wave = launder_s(wave);
    const int fr = lane & 15, fq = lane >> 4;
    const LAS float* tb = (const LAS float*)(lds + AT_TB);
    const int r4 = wave & 3, par = wave >> 2;
    const size_t tok0 = (size_t)b * SEQ + (size_t)(c0 + par) * 64 + 16 * r4;
    bf16x8 qf[4][2];
#pragma unroll
    for (int nq = 0; nq < 4; ++nq)
#pragma unroll
        for (int kk = 0; kk < 2; ++kk) qf[nq][kk] = *(const GAS bf16x8*)(PROJ + (tok0 + 128 * nq + fr) * NPROJ + h * 64 + 32 * kk + 8 * fq);
    f32x4 O[4][4], L[4];
    const bf16x8 ones8 = {(short)0x3f80, (short)0x3f80, (short)0x3f80, (short)0x3f80, (short)0x3f80, (short)0x3f80, (short)0x3f80, (short)0x3f80};
#pragma unroll
    for (int md = 0; md < 4; ++md)
#pragma unroll
        for (int nq = 0; nq < 4; ++nq) O[md][nq] = (f32x4){0.f, 0.f, 0.f, 0.f};
#pragma unroll
    for (int nq = 0; nq < 4; ++nq) L[nq] = (f32x4){0.f, 0.f, 0.f, 0.f};
    const int j0 = (c0 == 0) ? 8 : 0;
    const int skey = tid >> 3, sd = (tid & 7) * 8;
    const bf16* Kg = PROJ + ((size_t)b * SEQ + (size_t)((c0 - 8 + j0) * 64 + skey)) * NPROJ + 512 + h * 64 + sd;
    const LAS unsigned char* const rd0 = lds;
    LAS unsigned char* const wr0 = lds + skey * KP + sd * 2;
    const bf16* Kg2 = Kg + (size_t)64 * NPROJ;
    u32x4 pa[4], pb[4];
#define AT_GLOAD(dst) do { asm volatile("global_load_dwordx4 %0, %1, off" : "=&v"(dst[0]) : "v"(Kg) : "memory"); asm volatile("global_load_dwordx4 %0, %1, off offset:1024" : "=&v"(dst[1]) : "v"(Kg) : "memory"); \
        asm volatile("global_load_dwordx4 %0, %1, off" : "=&v"(dst[2]) : "v"(Kg2) : "memory"); asm volatile("global_load_dwordx4 %0, %1, off offset:1024" : "=&v"(dst[3]) : "v"(Kg2) : "memory"); \
        Kg += (size_t)128 * NPROJ; Kg2 += (size_t)128 * NPROJ; } while (0)
#define AT_WAIT4(src) asm volatile("s_waitcnt vmcnt(4)" : "+v"(src[0]), "+v"(src[1]), "+v"(src[2]), "+v"(src[3]) :: "memory")
#define AT_WAIT0(src) asm volatile("s_waitcnt vmcnt(0)" : "+v"(src[0]), "+v"(src[1]), "+v"(src[2]), "+v"(src[3]) :: "memory")
#define AT_STORE(src, stage) do { _Pragma("unroll") for (int q_ = 0; q_ < 4; ++q_) *(LAS u32x4*)(wr0 + (stage) * AT_STAGE + q_ * AT_TILE) = src[q_]; } while (0)
    asm volatile("s_waitcnt vmcnt(0)" ::: "memory");
    AT_GLOAD(pa); AT_WAIT0(pa); AT_STORE(pa, 0);
    AT_GLOAD(pb);
    AT_GLOAD(pa);
#define AT_QK(S, nq) do { _Pragma("unroll") for (int mk = 0; mk < 2; ++mk) _Pragma("unroll") for (int kk = 0; kk < 2; ++kk) S[mk] = __builtin_amdgcn_mfma_f32_16x16x32_bf16(kf[mk][kk], qf[nq][kk], S[mk], 0, 0, 0); } while (0)
#define AT_EXP(S, pb, nq) do { float p[8]; _Pragma("unroll") for (int i = 0; i < 4; ++i) { p[i] = __builtin_amdgcn_exp2f(S[0][i]); p[4 + i] = __builtin_amdgcn_exp2f(S[1][i]); } \
        const u32x4 pk = {cvtpk(p[0], p[1]), cvtpk(p[2], p[3]), cvtpk(p[4], p[5]), cvtpk(p[6], p[7])}; pb = __builtin_bit_cast(bf16x8, pk); } while (0)
#define AT_PV(pb, nq) do { _Pragma("unroll") for (int md = 0; md < 4; ++md) O[md][nq] = __builtin_amdgcn_mfma_f32_16x16x32_bf16(vf[md], pb, O[md][nq], 0, 0, 0); \
        L[nq] = __builtin_amdgcn_mfma_f32_16x16x32_bf16(ones8, pb, L[nq], 0, 0, 0); } while (0)
#define AT_QK_C(S, nq) do { _Pragma("unroll") for (int mk = 0; mk < 2; ++mk) { S[mk] = __builtin_amdgcn_mfma_f32_16x16x32_bf16(kf[mk][0], qf[nq][0], c4v, 0, 0, 0); S[mk] = __builtin_amdgcn_mfma_f32_16x16x32_bf16(kf[mk][1], qf[nq][1], S[mk], 0, 0, 0); } } while (0)
#define AT_INIT_T(S, nq) do { _Pragma("unroll") for (int mk = 0; mk < 2; ++mk) { const int base = 64 * t + 32 * sub - 384 + 16 * mk + 4 * fq - 16 * r4 - fr; \
        _Pragma("unroll") for (int i = 0; i < 4; ++i) { const int idx = base + i; S[mk][i] = tb[idx > 0 ? idx : 0]; } } } while (0)
#define AT_STEP(j, soff) do { \
        const float c0v = tb[0]; const f32x4 c4v = {c0v, c0v, c0v, c0v}; \
        _Pragma("unroll") for (int sub = 0; sub < 2; ++sub) { \
            const LAS unsigned char* kb = rd0 + (soff) + sub * 32 * KP; const LAS unsigned char* vb = kb + AT_TILE; \
            bf16x8 kf[2][2], vf[4]; \
            _Pragma("unroll") for (int mk = 0; mk < 2; ++mk) _Pragma("unroll") for (int kk = 0; kk < 2; ++kk) kf[mk][kk] = *(const LAS bf16x8*)(kb + (16 * mk + fr) * KP + (32 * kk + 8 * fq) * 2); \
            _Pragma("unroll") for (int md = 0; md < 4; ++md) { \
                const v4i16_t lo = __builtin_amdgcn_ds_read_tr16_b64_v4i16((LAS v4i16_t*)(vb + (4 * fq + (fr >> 2)) * KP + (16 * md + 4 * (fr & 3)) * 2)); \
                const v4i16_t hi = __builtin_amdgcn_ds_read_tr16_b64_v4i16((LAS v4i16_t*)(vb + (16 + 4 * fq + (fr >> 2)) * KP + (16 * md + 4 * (fr & 3)) * 2)); \
                vf[md] = (bf16x8){lo[0], lo[1], lo[2], lo[3], hi[0], hi[1], hi[2], hi[3]}; } \
            _Pragma("unroll") for (int nq = 0; nq < 4; ++nq) { \
                const int t = (j) - 2 * nq - par; \
                if (t >= 0 && t <= 8) { f32x4 S[2]; bf16x8 pb; \
                    if (t < 6) { AT_QK_C(S, nq); } else { AT_INIT_T(S, nq); AT_QK(S, nq); } \
                    AT_EXP(S, pb, nq); AT_PV(pb, nq); } \
            } \
        } } while (0)
    typedef short v4i16_t __attribute__((ext_vector_type(4)));
    for (int jp = j0 >> 1; jp < 8; jp += 2) {
        __syncthreads();
        AT_STEP(2 * jp, 0);
        AT_STEP(2 * jp + 1, 2 * AT_TILE);
        if (jp + 2 < 8) AT_WAIT4(pb); else AT_WAIT0(pb);
        AT_STORE(pb, 1);
        if (jp + 3 < 8) AT_GLOAD(pb);
        __syncthreads();
        AT_STEP(2 * jp + 2, AT_STAGE);
        AT_STEP(2 * jp + 3, AT_STAGE + 2 * AT_TILE);
        if (jp + 2 < 8) {
            if (jp + 3 < 8) AT_WAIT4(pa); else AT_WAIT0(pa);
            AT_STORE(pa, 0);
            if (jp + 4 < 8) AT_GLOAD(pa);
        }
    }
#undef AT_GLOAD
#undef AT_WAIT4
#undef AT_WAIT0
#undef AT_LOAD
#undef AT_STORE
#undef AT_STEP
#undef AT_BODY
#undef AT_QK
#undef AT_EXP
#undef AT_PV
#undef AT_QK_C
#undef AT_INIT_T
    const int lane3 = launder_v(lane_in), fr3 = lane3 & 15, fq3 = lane3 >> 4;
#pragma unroll
    for (int nq = 0; nq < 4; ++nq) {
        const float inv = 1.0f / L[nq][0];
        float ss = 0.f;
#pragma unroll
        for (int md = 0; md < 4; ++md) { O[md][nq] = O[md][nq] * inv; const f32x4 x = O[md][nq]; ss += (x[0] * x[0] + x[1] * x[1]) + (x[2] * x[2] + x[3] * x[3]); }
        ss += __shfl_xor(ss, 16); ss += __shfl_xor(ss, 32);
        if (fq3 == 0) (void)__hip_atomic_fetch_add(gp(ssq) + tok0 + 128 * nq + fr3, ss, __ATOMIC_RELAXED, __HIP_MEMORY_SCOPE_AGENT);
#pragma unroll
        for (int md = 0; md < 4; ++md) {
            const f32x4 y = O[md][nq];
            u32x2 w; w.x = cvtpk(y[0], y[1]); w.y = cvtpk(y[2], y[3]);
            *(GAS u32x2*)(YMIX + (tok0 + 128 * nq + fr3) * D + h * 64 + 16 * md + 4 * fq3) = w;
        }
    }
    __syncthreads();
}

__device__ __forceinline__ void conv_unit(const bf16* PROJ, bf16* YMIX, const float* w_conv, const float* b_conv, const float* g_conv, int b, int c, int wave, int lane_in) {
    {
        const int lane2 = launder_v(lane_in); wave = launder_s(wave);
        const int ch0 = 8 * lane2;
        float w0[8], w1[8], w2[8], bc[8], gc[8];
#pragma unroll
        for (int e = 0; e < 8; ++e) { w0[e] = gp(w_conv)[ch0 + e]; w1[e] = gp(w_conv)[512 + ch0 + e]; w2[e] = gp(w_conv)[1024 + ch0 + e]; bc[e] = gp(b_conv)[ch0 + e]; gc[e] = gp(g_conv)[ch0 + e]; }
        const int s0 = c * 64 + 8 * wave;
        const bf16* rowp = PROJ + ((size_t)b * SEQ + s0) * NPROJ + ch0;
        u32x4 xa[10], ga[10], gb[8];
#pragma unroll
        for (int r = 0; r < 10; ++r) { if (r >= 2 || s0 >= 2) { xa[r] = *(const GAS u32x4*)(rowp + (r - 2) * NPROJ + 1536); ga[r] = *(const GAS u32x4*)(rowp + (r - 2) * NPROJ + 2560); }
            else { xa[r] = (u32x4){0u, 0u, 0u, 0u}; ga[r] = xa[r]; } }
#pragma unroll
        for (int r = 0; r < 8; ++r) gb[r] = *(const GAS u32x4*)(rowp + r * NPROJ + 2048);
#define CV_U(dst, xv, gv) do { dst[0] = bf_lo(xv.x) * bf_lo(gv.x); dst[1] = bf_hi(xv.x) * bf_hi(gv.x); dst[2] = bf_lo(xv.y) * bf_lo(gv.y); dst[3] = bf_hi(xv.y) * bf_hi(gv.y); \
        dst[4] = bf_lo(xv.z) * bf_lo(gv.z); dst[5] = bf_hi(xv.z) * bf_hi(gv.z); dst[6] = bf_lo(xv.w) * bf_lo(gv.w); dst[7] = bf_hi(xv.w) * bf_hi(gv.w); } while (0)
        float u0[8], u1[8];
        CV_U(u0, xa[0], ga[0]); CV_U(u1, xa[1], ga[1]);
#pragma unroll
        for (int r = 0; r < 8; ++r) {
            float u2[8]; CV_U(u2, xa[r + 2], ga[r + 2]);
            const u32x4 gbv = gb[r];
            float gbf[8] = {bf_lo(gbv.x), bf_hi(gbv.x), bf_lo(gbv.y), bf_hi(gbv.y), bf_lo(gbv.z), bf_hi(gbv.z), bf_lo(gbv.w), bf_hi(gbv.w)};
            float y[8]; float ss = 0.f;
#pragma unroll
            for (int e = 0; e < 8; ++e) { y[e] = gbf[e] * (w0[e] * u0[e] + w1[e] * u1[e] + w2[e] * u2[e] + bc[e]); ss += y[e] * y[e]; }
            const float rstd = 1.0f / sqrtf(wave_sum(ss) * (1.0f / 512.0f) + EPS);
            u32x4 o;
            o.x = cvtpk(y[0] * rstd * gc[0], y[1] * rstd * gc[1]); o.y = cvtpk(y[2] * rstd * gc[2], y[3] * rstd * gc[3]);
            o.z = cvtpk(y[4] * rstd * gc[4], y[5] * rstd * gc[5]); o.w = cvtpk(y[6] * rstd * gc[6], y[7] * rstd * gc[7]);
            *(GAS u32x4*)(YMIX + ((size_t)b * SEQ + s0 + r) * D + 512 + ch0) = o;
#pragma unroll
            for (int e = 0; e < 8; ++e) { u0[e] = u1[e]; u1[e] = u2[e]; }
        }
#undef CV_U
    }
}

#define XB_TMO      128
#define XB_XCNT(j)  (256  + 64 * (j))
#define XB_XSUB(j)  (1280 + 64 * (j))
#define XB_XGEN(j)  (2304 + 64 * (j))
#define XB_TOP      3328
#define XB_TOPGEN   3392
#define XCD_BAR_WORDS 3456
#define XB_SPIN_CAP (1u << 18)

__device__ __forceinline__ unsigned xb_ld(unsigned* p)              { return __hip_atomic_load(p, __ATOMIC_RELAXED, __HIP_MEMORY_SCOPE_AGENT); }
__device__ __forceinline__ unsigned xb_add(unsigned* p, unsigned v) { return __hip_atomic_fetch_add(p, v, __ATOMIC_RELAXED, __HIP_MEMORY_SCOPE_AGENT); }
__device__ __forceinline__ unsigned xb_xcc_id() { return (unsigned)__builtin_amdgcn_s_getreg((3 << 11) | 20) & 0xFu; }
#define XB_SPIN(cond, bar) do { unsigned _sp = 0; while (cond) { __builtin_amdgcn_s_sleep(1); \
    if ((++_sp & 255u) == 0u) { if (xb_ld(&(bar)[XB_TMO])) break; if (_sp > XB_SPIN_CAP) { atomicAdd(&(bar)[XB_TMO], 1u); break; } } } } while (0)

struct XcdBarrier {
    unsigned* bar; unsigned x;
    volatile LAS unsigned* st;
};

__device__ __forceinline__ XcdBarrier xcd_barrier_post(unsigned* bar, volatile LAS unsigned* st) {
    XcdBarrier b; b.bar = bar; b.x = xb_xcc_id(); b.st = st;
    if (threadIdx.x == 0) (void)xb_add(&bar[XB_XCNT(b.x)], 1u);
    return b;
}
__device__ __forceinline__ void xcd_barrier_complete(unsigned* bar, unsigned x, unsigned& nloc, unsigned& nx) {
    const unsigned G = gridDim.x * gridDim.y * gridDim.z;
    unsigned sum, cnt, mine, sp = 0u;
    for (;;) {
        sum = 0u; cnt = 0u;
#pragma unroll
        for (unsigned j = 0; j < 16; ++j) { const unsigned c = xb_ld(&bar[XB_XCNT(j)]); sum += c; cnt += (c > 0u) ? 1u : 0u; }
        mine = xb_ld(&bar[XB_XCNT(x)]);
        if (sum == G) break;
        __builtin_amdgcn_s_sleep(1);
        if ((++sp & 255u) == 0u) { if (xb_ld(&bar[XB_TMO])) break; if (sp > XB_SPIN_CAP) { atomicAdd(&bar[XB_TMO], 1u); break; } }
    }
    nloc = mine > 0u ? mine : 1u; nx = cnt > 0u ? cnt : 1u;
}

__device__ __forceinline__ void xcd_barrier(const XcdBarrier& b_in, const bool is_t0) {
    XcdBarrier b = b_in; b.x = (unsigned)launder_s(__builtin_amdgcn_readfirstlane((int)b_in.x)); b.bar = launder(b_in.bar);
    asm volatile("s_waitcnt vmcnt(0)" ::: "memory");
    __syncthreads();
    if (is_t0) {
        unsigned* bar = b.bar;
        __builtin_amdgcn_s_waitcnt(0);
        unsigned nloc = b.st[0], nx = b.st[1];
        if (nloc == 0u) { xcd_barrier_complete(bar, b.x, nloc, nx); b.st[0] = nloc; b.st[1] = nx; }
        const unsigned old = xb_add(&bar[XB_XSUB(b.x)], 1u);
        const unsigned gen = old / nloc;
        if (old + 1u == (gen + 1u) * nloc) {
            __builtin_amdgcn_fence(__ATOMIC_RELEASE, "agent");
            asm volatile("s_waitcnt vmcnt(0)" ::: "memory");
            const unsigned og = xb_add(&bar[XB_TOP], 1u);
            const unsigned tg = og / nx;
            if (og + 1u == (tg + 1u) * nx) xb_add(&bar[XB_TOPGEN], 1u);
            else XB_SPIN(xb_ld(&bar[XB_TOPGEN]) == tg, bar);
            __builtin_amdgcn_fence(__ATOMIC_ACQUIRE, "agent");
            xb_add(&bar[XB_XGEN(b.x)], 1u);
            asm volatile("s_waitcnt vmcnt(0)" ::: "memory");
        } else {
            XB_SPIN(xb_ld(&bar[XB_XGEN(b.x)]) == gen, bar);
            __builtin_amdgcn_fence(__ATOMIC_ACQUIRE, "agent");
            asm volatile("s_waitcnt vmcnt(0)" ::: "memory");
        }
    }
    __syncthreads();
}

struct Args {
    const float *x, *c, *w_ada, *b_ada, *g_norm, *w_ffn1_in, *w_ffn1_out, *w_in, *q_norm_g, *k_norm_g, *rel_bias, *w_conv, *b_conv, *g_attn_out, *g_conv_out, *w_out, *w_ffn2_in, *w_ffn2_out, *g_final;
    float* out; unsigned char* ws;
    int rep_norm, rep_up, rep_proj, rep_att, rep_conv, rep_res0, rep_sync, pad;
};

__global__ void __launch_bounds__(NWAVES * 64, 2) fwd_megakernel(Args a_unused) {
#define KARG(f) (kargp[opaque_zero()].f)
    typedef const __attribute__((address_space(4))) Args* kargp_t;
    const kargp_t kargp = (kargp_t)__builtin_amdgcn_kernarg_segment_ptr();
    extern __shared__ __attribute__((aligned(16))) unsigned char lds_raw[];
    cg::grid_group grid = cg::this_grid();
    LAS unsigned char* lds = (LAS unsigned char*)lds_raw;
    const int wave = __builtin_amdgcn_readfirstlane((int)threadIdx.x >> 6);
#define FRESH_LANE() fresh_lane()
#define FRESH_TID() (launder_s(wave) * 64 + fresh_lane())
    constexpr int G = 256; const int bx = blockIdx.x;
    const int gw = bx * NWAVES + wave, NGW = G * NWAVES;
    unsigned char* ws = KARG(ws);
    float* mod = (float*)(ws + WS_MOD);
#define GRID_BAR() xcd_barrier(xbar, FRESH_TID() == 0)
    volatile LAS unsigned* bst = (volatile LAS unsigned*)(lds + 131072 + 64);
    { const int t0 = FRESH_TID(); if (t0 < 2) bst[t0] = 0u; }
    __syncthreads();
    const XcdBarrier xbar = xcd_barrier_post((unsigned*)(ws + WS_BAR), bst);

    {
        const int it = wave * G + bx;
        if (wave < 3 && it < 16 * 36) mod_item(KARG(c), KARG(w_ada), KARG(b_ada), mod, it, FRESH_LANE());
    }
    if (KARG(rep_sync) < 0) grid.sync();
    GRID_BAR();
    {
        constexpr int I_IN = (D / 64) * (2 * DFF / 32), I_OUT = (DFF / 64) * (D / 32), I_PROJ = (D / 64) * (NPROJ / 32), I_WO = (D / 64) * (D / 32);
        constexpr int NITEMS = 2 * I_IN + 2 * I_OUT + I_PROJ + I_WO;
        LAS float* scr = (LAS float*)(lds + wave * 16384); const int lane = FRESH_LANE();
        for (int it = gw; it < NITEMS; it += NGW) {
            int r = it;
            if (r < 2 * I_IN) { const int f = r >= I_IN; r -= f * I_IN; const int nblk = 2 * DFF / 32, kb = r / nblk, nb = r % nblk;
                transpose_item(f ? KARG(w_ffn2_in) : KARG(w_ffn1_in), D, 2 * DFF, (bf16*)(ws + (f ? WS_W2IN : WS_W1IN)), 64 * kb, 32 * nb, drow_swiglu(32 * nb), scr, lane); continue; } r -= 2 * I_IN;
            if (r < 2 * I_OUT) { const int f = r >= I_OUT; r -= f * I_OUT; const int nblk = D / 32, kb = r / nblk, nb = r % nblk;
                transpose_item(f ? KARG(w_ffn2_out) : KARG(w_ffn1_out), DFF, D, (bf16*)(ws + (f ? WS_W2OUT : WS_W1OUT)), 64 * kb, 32 * nb, drow_plain(32 * nb), scr, lane); continue; } r -= 2 * I_OUT;
            if (r < I_PROJ) { const int nblk = NPROJ / 32, kb = r / nblk, nb = r % nblk;
                transpose_item(KARG(w_in), D, NPROJ, (bf16*)(ws + WS_WIN), 64 * kb, 32 * nb, drow_proj(32 * nb), scr, lane); continue; } r -= I_PROJ;
            { const int nblk = D / 32, kb = r / nblk, nb = r % nblk;
                transpose_item(KARG(w_out), D, D, (bf16*)(ws + WS_WOUT), 64 * kb, 32 * nb, drow_plain(32 * nb), scr, lane, kb < 8 ? KARG(g_attn_out) : nullptr); }
        }
    }

    for (int step = 0; step < 3; ++step) {
        unsigned char* wsl = launder(ws);
        float* modl = (float*)(wsl + WS_MOD);
        {
            bf16* XNl = (bf16*)(wsl + WS_XN); const int ln = FRESH_LANE();
            if (step == 0) { const float* xin = launder(KARG(x));
                for (int rep = 0; rep < KARG(rep_norm); ++rep)
                for (int it = 0, m = gw; it < M / (4 * NGW); ++it, m += 4 * NGW) {
                    const float* mb = modl + (m >> 13) * NMOD + step * 3072;
                    norm_rows_bf16<4>(xin, XNl, m, NGW, KARG(g_norm) + step * D, mb, mb + 1024, ln); }
            }
        }
        if (step == 0) GRID_BAR();
        const bf16* A2; const bf16* B2; int K2;
        if (step != 1) {
            unsigned char* w2 = launder(wsl);
            pg8::Gemm g{(const bf16*)(w2 + (step == 0 ? WS_XN : WS_XN2)), (const bf16*)(w2 + (step == 0 ? WS_W1IN : WS_W2IN)), M, 2 * DFF, D}; pg8::StaticOrder S; S.init(M, 2 * DFF, G, bx);
            pg8::EpiSwiglu E{(bf16*)(w2 + WS_ACT), DFF};
            for (int rep = 0; rep < KARG(rep_up); ++rep)
            pg8::gemm_phase<pg8::EpiSwiglu, pg8::StaticOrder, true, true>(lds, g, S, E, FRESH_TID());
            GRID_BAR();
            A2 = (const bf16*)(wsl + WS_ACT); B2 = (const bf16*)(wsl + (step == 0 ? WS_W1OUT : WS_W2OUT)); K2 = DFF;
        } else {
            {
                unsigned char* w2 = launder(wsl);
                pg8::Gemm g{(const bf16*)(w2 + WS_XN), (const bf16*)(w2 + WS_WIN), M, NPROJ, D}; pg8::StaticOrder S; S.init(M, NPROJ, G, bx);
                pg8::EpiProj E{(bf16*)(w2 + WS_ACT), KARG(q_norm_g), KARG(k_norm_g)};
                for (int rep = 0; rep < KARG(rep_proj); ++rep)
                pg8::gemm_phase<pg8::EpiProj, pg8::StaticOrder, true, true>(lds, g, S, E, FRESH_TID());
            }
            GRID_BAR();
            {
                unsigned char* w2 = launder(wsl); const int ln = FRESH_LANE();
                const int vcu = (G % 8 == 0) ? (bx % 8) * (G / 8) + bx / 8 : bx;
                float* ssq = (float*)(w2 + WS_SSQ);
                attn_bias_table(lds, KARG(rel_bias), KARG(q_norm_g), KARG(k_norm_g), ((vcu * 4) >> 4) & 7, FRESH_LANE(), FRESH_TID());
                for (int rep = 0; rep < KARG(rep_att); ++rep)
                for (int j = 0; j < 4; ++j) {
                    const int uu = vcu * 4 + j;
                    attn_unit(lds, (const bf16*)(w2 + WS_ACT), (bf16*)(w2 + WS_XN), rep == 0 ? ssq : ssq + M, KARG(rel_bias), KARG(q_norm_g), KARG(k_norm_g), uu >> 7, (uu >> 4) & 7, 8 * (uu & 15), wave, FRESH_LANE(), FRESH_TID());
                }
                for (int rep = 0; rep < KARG(rep_conv); ++rep)
                for (int uu = vcu * 4; uu < vcu * 4 + 4; ++uu)
                    conv_unit((const bf16*)(w2 + WS_ACT), (bf16*)(w2 + WS_XN), KARG(w_conv), KARG(b_conv), KARG(g_conv_out), uu >> 7, uu & 127, wave, FRESH_LANE());
            }
            GRID_BAR();
            A2 = (const bf16*)(wsl + WS_XN); B2 = (const bf16*)(wsl + WS_WOUT); K2 = D;
        }
        {
            pg8::Gemm g{launder(A2), launder(B2), M, D, K2}; pg8::StaticOrder S; S.init(M, D, G, bx);
            pg8::EpiResid E{launder(KARG(x)), (bf16*)(wsl + WS_XS), launder(modl), (const float*)(wsl + WS_SSQ), step < 2 ? KARG(g_norm) + (step + 1) * D : KARG(g_final),
                            (bf16*)(wsl + (step == 0 ? WS_XN : WS_XN2)), launder(KARG(out)), (float*)(wsl + WS_XBUF) + (size_t)step * M * 4, (unsigned*)(wsl + WS_CNT) + step * 256, lds + 131072 + 1024, step, step == 1 ? 8 : -1};
            for (int rep = 0; rep < (step == 0 ? KARG(rep_res0) : 1); ++rep)
            pg8::gemm_phase<pg8::EpiResid, pg8::StaticOrder, true, true>(lds, g, S, E, FRESH_TID());
        }
        if (step < 2) GRID_BAR();
        for (int rep = 0; rep < KARG(rep_sync); ++rep) GRID_BAR();
    }
}

extern "C" void kernel_launch(void* const* d_in, const int* in_sizes, int n_in, void* d_out, int out_size, void* d_ws, size_t ws_size, hipStream_t stream) {
    static int grid = 0;
    if (grid == 0) {
        if (n_in != 19 || out_size != M * D || ws_size < WS_END) { fprintf(stderr, "kernel_launch: unexpected shapes (n_in %d out %d ws %zu)\n", n_in, out_size, ws_size); grid = -1; return; }
        int dev = 0, cus = 0, per_cu = 0;
        (void)hipGetDevice(&dev);
        (void)hipDeviceGetAttribute(&cus, hipDeviceAttributeMultiprocessorCount, dev);
        if (hipFuncSetAttribute((const void*)fwd_megakernel, hipFuncAttributeMaxDynamicSharedMemorySize, LDS_BYTES) != hipSuccess) { fprintf(stderr, "kernel_launch: hipFuncSetAttribute failed\n"); grid = -1; return; }
        if (hipOccupancyMaxActiveBlocksPerMultiprocessor(&per_cu, (const void*)fwd_megakernel, NWAVES * 64, LDS_BYTES) != hipSuccess || per_cu < 1) { fprintf(stderr, "kernel_launch: occupancy query says %d\n", per_cu); per_cu = 1; }
        (void)hipGetLastError();
        grid = cus * per_cu;
        if (grid > 256) grid = 256;
        if (grid != 256) { fprintf(stderr, "kernel_launch: this kernel is built for a 256-workgroup grid, got %d; nothing launched\n", grid); grid = -1; return; }
        fprintf(stderr, "kernel_launch: grid %d (cus %d per_cu %d)\n", grid, cus, per_cu);
    }
    if (grid < 0) return;
    (void)hipMemsetAsync((char*)d_ws + WS_MOD, 0, CTL_ZERO_BYTES, stream);
    Args a{};
    const float** ap = (const float**)&a;
    for (int i = 0; i < 19; ++i) ap[i] = (const float*)d_in[i];
    a.out = (float*)d_out; a.ws = (unsigned char*)d_ws;
    a.rep_norm = KN_NORM; a.rep_up = KN_UP; a.rep_proj = KN_PROJ; a.rep_att = KN_ATT; a.rep_conv = KN_CONV; a.rep_res0 = KN_RES0; a.rep_sync = KN_SYNC; a.pad = 0;
    void* args[] = {&a};
    hipError_t e = hipLaunchCooperativeKernel((const void*)fwd_megakernel, dim3(grid), dim3(NWAVES * 64), args, LDS_BYTES, stream);
    if (e != hipSuccess) fprintf(stderr, "cooperative launch failed: %s (grid %d)\n", hipGetErrorString(e), grid);
}
```

```cpp
#include <hip/hip_runtime.h>
#include <hip/hip_cooperative_groups.h>
#include <cstdio>
#include <cstdint>
namespace cg = cooperative_groups;
namespace pg8 {
#define PG8_LAS __attribute__((address_space(3)))
typedef unsigned short bf16_t;
typedef short bf16x8 __attribute__((ext_vector_type(8)));
typedef float f32x4 __attribute__((ext_vector_type(4)));
typedef unsigned u32x4 __attribute__((ext_vector_type(4)));
constexpr int BM = 256, BK = 64, HALF = 128, HTB = HALF * BK * 2  , STAGE_BYTES = 8 * HTB, NXCD = 8, WGM = 8;

__host__ __device__ __forceinline__ int lds_byte(int r, int c) { const int st = (r >> 4) * 2 + (c >> 5), rr = r & 15, cc = c & 31, ob = rr * 64 + cc * 2; return st * 1024 + (ob ^ (((ob >> 9) & 1) << 5)); }
__host__ __device__ __forceinline__ void stage_rc(int b, int& R, int& C) { const int st = b / 1024, sb = b % 1024, swz = sb ^ (((sb >> 9) & 1) << 5); R = (st >> 1) * 16 + swz / 64; C = (st & 1) * 32 + (swz % 64) / 2; }
__host__ __device__ __forceinline__ int perm32(int rho) { const int n = rho >> 4, i = rho & 15; return 8 * (i >> 2) + 4 * n + (i & 3); }

struct Unit { int pm, pn; };
struct Gemm { const bf16_t* A; const bf16_t* Bt; int M, N, K; };

struct StaticOrder {
    int nM, nN, nwg, G, c;
    __host__ __device__ void init(int M, int N, int G_, int c_) { nM = M / BM; nN = N / BM; nwg = nM * nN; G = G_; c = c_; }
    __host__ __device__ bool next(int i, Unit& u) const {
        const long L = (long)i * G + c; if (L >= nwg) return false;
        int wgid = (int)L; { const int q = nwg / NXCD, r = nwg % NXCD, xcd = wgid % NXCD, off = wgid / NXCD; wgid = (xcd < r ? xcd * (q + 1) : r * (q + 1) + (xcd - r) * q) + off; }
        const int nig = WGM * nN, gid = wgid / nig, fm = gid * WGM, gsz = (nM - fm) < WGM ? (nM - fm) : WGM;
        u.pm = fm + ((wgid % nig) % gsz); u.pn = (wgid % nig) / gsz; return true;
    }
    __device__ __forceinline__ void a_ready(const Unit&) const {}
    __device__ __forceinline__ void done(const Unit&) const {}
};


#define PG8_GAS __attribute__((address_space(1)))
typedef float f32x2 __attribute__((ext_vector_type(2)));
typedef __bf16 bf16x2_t __attribute__((ext_vector_type(2)));
__device__ __forceinline__ unsigned cvtpk(float lo, float hi) { f32x2 v = {lo, hi}; bf16x2_t b = __builtin_convertvector(v, bf16x2_t); return __builtin_bit_cast(unsigned, b); }
__device__ __forceinline__ float silu_mul(float g, float u) { return g * u * __builtin_amdgcn_rcpf(1.0f + __builtin_amdgcn_exp2f(-1.4426950408889634f * g)); }

struct EpiSwiglu {
    static constexpr bool PERM = true, AFTER_DRAIN = false, MIDK = false;
    bf16_t* O; int ldc;
    __device__ __forceinline__ void operator()(const f32x4 (&acc)[2][2][4][2], const Unit& u, int wr, int wc, int fr, int fq) const {
        const int row0 = u.pm * BM + wr * 64 + fr, col0 = u.pn * HALF + wc * 32 + 8 * fq;
#pragma unroll
        for (int ai = 0; ai < 2; ++ai)
#pragma unroll
            for (int m = 0; m < 4; ++m) {
                bf16_t* p = O + (size_t)(row0 + ai * HALF + m * 16) * ldc + col0;
                const f32x4 g0 = acc[ai][0][m][0], g1 = acc[ai][0][m][1], u0 = acc[ai][1][m][0], u1 = acc[ai][1][m][1];
                u32x4 w;
                w.x = cvtpk(silu_mul(g0[0], u0[0]), silu_mul(g0[1], u0[1])); w.y = cvtpk(silu_mul(g0[2], u0[2]), silu_mul(g0[3], u0[3]));
                w.z = cvtpk(silu_mul(g1[0], u1[0]), silu_mul(g1[1], u1[1])); w.w = cvtpk(silu_mul(g1[2], u1[2]), silu_mul(g1[3], u1[3]));
                *(PG8_GAS u32x4*)p = w;
            }
    }
};
struct EpiResid {
    static constexpr bool PERM = true, AFTER_DRAIN = false, MIDK = true;
    const float* xin; bf16_t* xs; const float* mod; const float* ssq; int step, midk;
    __device__ __forceinline__ void mid(f32x4 (&acc)[2][2][4][2], const Unit& u, int wr, int fr_in) const {
        int fr = fr_in; asm volatile("" : "+v"(fr));
#pragma unroll
        for (int ai = 0; ai < 2; ++ai)
#pragma unroll
            for (int m = 0; m < 4; ++m) {
                const float s = 1.0f / sqrtf(((const PG8_GAS float*)ssq)[u.pm * BM + ai * HALF + wr * 64 + m * 16 + fr] * (1.0f / 512.0f) + 1e-6f);
#pragma unroll
                for (int bj = 0; bj < 2; ++bj)
#pragma unroll
                    for (int n = 0; n < 2; ++n) acc[ai][bj][m][n] = acc[ai][bj][m][n] * s;
            }
    }
    __device__ __forceinline__ void operator()(const f32x4 (&acc)[2][2][4][2], const Unit& u, int wr, int wc, int fr, int fq) const {
        const int b = (u.pm * BM) >> 13;
        const float* gp = mod + b * 9216 + step * 3072 + 2048; const float coef = step == 1 ? 1.0f : 0.5f;
        const float* basef = step == 0 ? xin : (const float*)nullptr; const bf16_t* baseb = xs; bf16_t* out = xs;
        const int col0 = u.pn * BM + wc * 32 + 8 * fq;
        f32x4 gv[2][2];
#pragma unroll
        for (int bj = 0; bj < 2; ++bj)
#pragma unroll
            for (int n = 0; n < 2; ++n) gv[bj][n] = (*(const PG8_GAS f32x4*)(gp + col0 + bj * HALF + 4 * n) + 1.0f) * coef;
#pragma unroll
        for (int ai = 0; ai < 2; ++ai)
#pragma unroll
            for (int m = 0; m < 4; ++m) {
                const size_t off = (size_t)(u.pm * BM + ai * HALF + wr * 64 + m * 16 + fr) * 1024 + col0;
#pragma unroll
                for (int bj = 0; bj < 2; ++bj) {
                    f32x4 b0, b1;
                    if (basef) { b0 = *(const PG8_GAS f32x4*)(basef + off + bj * HALF); b1 = *(const PG8_GAS f32x4*)(basef + off + bj * HALF + 4); }
                    else { const u32x4 w = *(const PG8_GAS u32x4*)(baseb + off + bj * HALF);
                        b0 = (f32x4){__uint_as_float(w.x << 16), __uint_as_float(w.x & 0xffff0000u), __uint_as_float(w.y << 16), __uint_as_float(w.y & 0xffff0000u)};
                        b1 = (f32x4){__uint_as_float(w.z << 16), __uint_as_float(w.z & 0xffff0000u), __uint_as_float(w.w << 16), __uint_as_float(w.w & 0xffff0000u)}; }
                    const f32x4 o0 = b0 + gv[bj][0] * acc[ai][bj][m][0], o1 = b1 + gv[bj][1] * acc[ai][bj][m][1];
                    u32x4 w; w.x = cvtpk(o0[0], o0[1]); w.y = cvtpk(o0[2], o0[3]); w.z = cvtpk(o1[0], o1[1]); w.w = cvtpk(o1[2], o1[3]);
                    *(PG8_GAS u32x4*)(out + off + bj * HALF) = w;
                }
            }
    }
};
struct EpiProj {
    static constexpr bool PERM = true, AFTER_DRAIN = false, MIDK = false;
    bf16_t* O; const float* gq; const float* gk;
    __device__ __forceinline__ void operator()(const f32x4 (&acc)[2][2][4][2], const Unit& u, int wr, int wc, int fr, int fq) const {
        const int row0 = u.pm * BM + wr * 64 + fr, colh = u.pn * BM + wc * 64 + 8 * fq;
        if (u.pn < 4) {
            const float* g = (u.pn < 2) ? gq : gk; const float sc = (u.pn < 2) ? 0.125f * 1.4426950408889634f : 1.0f;
            f32x4 gv[2][2];
#pragma unroll
            for (int bj = 0; bj < 2; ++bj)
#pragma unroll
                for (int n = 0; n < 2; ++n) gv[bj][n] = *(const PG8_GAS f32x4*)(g + 32 * bj + 8 * fq + 4 * n) * sc;
#pragma unroll
            for (int ai = 0; ai < 2; ++ai)
#pragma unroll
                for (int m = 0; m < 4; ++m) {
                    float ss = 0.f;
#pragma unroll
                    for (int bj = 0; bj < 2; ++bj)
#pragma unroll
                        for (int n = 0; n < 2; ++n) { const f32x4 x = acc[ai][bj][m][n]; ss += (x[0] * x[0] + x[1] * x[1]) + (x[2] * x[2] + x[3] * x[3]); }
                    ss += __shfl_xor(ss, 16); ss += __shfl_xor(ss, 32);
                    const float rstd = 1.0f / sqrtf(ss * (1.0f / 64.0f) + 1e-6f);
                    bf16_t* p = O + (size_t)(row0 + ai * HALF + m * 16) * 3072 + colh;
#pragma unroll
                    for (int bj = 0; bj < 2; ++bj) {
                        const f32x4 v0 = acc[ai][bj][m][0] * rstd * gv[bj][0], v1 = acc[ai][bj][m][1] * rstd * gv[bj][1];
                        u32x4 w; w.x = cvtpk(v0[0], v0[1]); w.y = cvtpk(v0[2], v0[3]); w.z = cvtpk(v1[0], v1[1]); w.w = cvtpk(v1[2], v1[3]);
                        *(PG8_GAS u32x4*)(p + 32 * bj) = w;
                    }
                }
        } else {
#pragma unroll
            for (int ai = 0; ai < 2; ++ai)
#pragma unroll
                for (int m = 0; m < 4; ++m) {
                    bf16_t* p = O + (size_t)(row0 + ai * HALF + m * 16) * 3072 + colh;
#pragma unroll
                    for (int bj = 0; bj < 2; ++bj) {
                        const f32x4 v0 = acc[ai][bj][m][0], v1 = acc[ai][bj][m][1];
                        u32x4 w; w.x = cvtpk(v0[0], v0[1]); w.y = cvtpk(v0[2], v0[3]); w.z = cvtpk(v1[0], v1[1]); w.w = cvtpk(v1[2], v1[3]);
                        *(PG8_GAS u32x4*)(p + 32 * bj) = w;
                    }
                }
        }
    }
};

template <class Epi, class Sched, bool ALIGN_EPI = false, bool SP2 = false>
__device__ __forceinline__ void gemm_phase(PG8_LAS unsigned char* lds, const Gemm g, const Sched& S, const Epi& E, const int tid) {
    const int  wid = __builtin_amdgcn_readfirstlane(tid >> 6), lane = tid & 63, wr = wid >> 2, wc = wid & 3, fr = lane & 15, fq = lane >> 4;
    const int K = g.K, nt = K / BK;
    unsigned voffA[2], voffB[2];
#pragma unroll
    for (int i = 0; i < 2; ++i) { int R, C; stage_rc(tid * 16 + i * 8192, R, C); const int Rb = Epi::PERM ? ((R & ~31) + perm32(R & 31)) : R;
        voffA[i] = (unsigned)(R * K + C) * 2u; voffB[i] = (unsigned)(Rb * K + C) * 2u; }
    const size_t kstep = (size_t)(BK * 2);
    const size_t hstep = (size_t)HALF * K * 2;
    const size_t tstep = 2 * hstep;
    const unsigned ldsw = (unsigned)wid * 1024u;
    const int aoff = lds_byte(wr * 64 + fr, fq * 8), boff = lds_byte(wc * 32 + fr, fq * 8);
#define PG8_SA(b, h) (((b) * 2 + (h)) * HTB)
#define PG8_SB(b, h) ((4 + (b) * 2 + (h)) * HTB)
#define PG8_STAGE(bufoff, gbase, voff) do { _Pragma("unroll") for (int _i = 0; _i < 2; ++_i) \
        __builtin_amdgcn_global_load_lds((const unsigned*)((const char*)(gbase) + (voff)[_i]), (PG8_LAS unsigned*)(lds + (bufoff) + ldsw + _i * 8192), 16, 0, 0); } while (0)
#define PG8_LDA(dst, b, h) do { _Pragma("unroll") for (int m = 0; m < 4; ++m) _Pragma("unroll") for (int k = 0; k < 2; ++k) dst[m][k] = *(const PG8_LAS bf16x8*)(lds + PG8_SA(b, h) + aoff + m * 2048 + k * 1024); } while (0)
#define PG8_LDB(dst, b, h) do { _Pragma("unroll") for (int n = 0; n < 2; ++n) _Pragma("unroll") for (int k = 0; k < 2; ++k) dst[n][k] = *(const PG8_LAS bf16x8*)(lds + PG8_SB(b, h) + boff + n * 2048 + k * 1024); } while (0)
#define PG8_MMA(ai, bj, At, Bt) do { __builtin_amdgcn_s_setprio(1); _Pragma("unroll") for (int m = 0; m < 4; ++m) _Pragma("unroll") for (int n = 0; n < 2; ++n) _Pragma("unroll") for (int k = 0; k < 2; ++k) \
        acc[ai][bj][m][n] = __builtin_amdgcn_mfma_f32_16x16x32_bf16(Bt[n][k], At[m][k], acc[ai][bj][m][n], 0, 0, 0); __builtin_amdgcn_s_setprio(0); } while (0)
#define PG8_WAIT_V(n) asm volatile("s_waitcnt vmcnt(" #n ")" ::: "memory")
#define PG8_WAIT_L(n) asm volatile("s_waitcnt lgkmcnt(" #n ")" ::: "memory")
#define PG8_BAR __builtin_amdgcn_s_barrier()
#define PG8_SCHED __builtin_amdgcn_sched_barrier(0)
    Unit cur, nxt; int ui = 0;
    if (!S.next(0, cur)) return;
    f32x4 acc[2][2][4][2];
#pragma unroll
    for (int a = 0; a < 2; ++a)
#pragma unroll
        for (int b = 0; b < 2; ++b)
#pragma unroll
            for (int m = 0; m < 4; ++m)
#pragma unroll
                for (int n = 0; n < 2; ++n) acc[a][b][m][n] = (f32x4){0.f, 0.f, 0.f, 0.f};
    bf16x8 At[4][2], B0[2][2], B1[2][2];
    const char* cA = (const char*)g.A + (size_t)cur.pm * tstep; const char* cB = (const char*)g.Bt + (size_t)cur.pn * tstep;
    S.a_ready(cur);
    if constexpr (SP2) {
        PG8_STAGE(PG8_SB(0, 0), cB, voffB); PG8_STAGE(PG8_SB(0, 1), cB + hstep, voffB); PG8_STAGE(PG8_SA(0, 0), cA, voffA); PG8_STAGE(PG8_SA(0, 1), cA + hstep, voffA);
        if (wr == 1) PG8_BAR;
        PG8_WAIT_V(2); PG8_BAR;
        PG8_STAGE(PG8_SB(1, 0), cB + kstep, voffB); PG8_STAGE(PG8_SA(1, 0), cA + kstep, voffA); PG8_STAGE(PG8_SB(1, 1), cB + hstep + kstep, voffB);
        PG8_WAIT_V(6); PG8_BAR;
    } else {
        PG8_STAGE(PG8_SB(0, 0), cB, voffB); PG8_STAGE(PG8_SA(0, 0), cA, voffA); PG8_STAGE(PG8_SB(0, 1), cB + hstep, voffB); PG8_STAGE(PG8_SA(0, 1), cA + hstep, voffA);
        if (wr == 1) PG8_BAR;
        PG8_WAIT_V(4); PG8_BAR;
        PG8_STAGE(PG8_SB(1, 0), cB + kstep, voffB); PG8_STAGE(PG8_SA(1, 0), cA + kstep, voffA); PG8_STAGE(PG8_SB(1, 1), cB + hstep + kstep, voffB);
        PG8_WAIT_V(6); PG8_BAR;
    }
    for (;;) {
        const bool has_next = S.next(ui + 1, nxt);
        const char* nA = has_next ? (const char*)g.A + (size_t)nxt.pm * tstep : cA; const char* nB = has_next ? (const char*)g.Bt + (size_t)nxt.pn * tstep : cB;
        for (int t = 0; t < nt; t += 2) {
            if constexpr (Epi::MIDK) { if (t == E.midk) E.mid(acc, cur, wr, fr); }
            const bool last = (t == nt - 2);
            const char* a1 = cA + (size_t)(t + 1) * kstep;
            const char* a2 = last ? nA : cA + (size_t)(t + 2) * kstep; const char* b2 = last ? nB : cB + (size_t)(t + 2) * kstep;
            const char* a3 = a2 + kstep; const char* b3 = b2 + kstep;
            if (last && has_next) S.a_ready(nxt);
            if constexpr (SP2) {
            PG8_LDB(B0, 0, 0); PG8_LDB(B1, 0, 1); PG8_SCHED; PG8_LDA(At, 0, 0); PG8_STAGE(PG8_SA(1, 1), a1 + hstep, voffA);
            PG8_WAIT_V(8); PG8_WAIT_L(0); PG8_BAR; PG8_MMA(0, 0, At, B0); PG8_MMA(0, 1, At, B1); PG8_BAR; PG8_SCHED;
            PG8_LDA(At, 0, 1); PG8_STAGE(PG8_SB(0, 0), b2, voffB); PG8_STAGE(PG8_SB(0, 1), b2 + hstep, voffB); PG8_STAGE(PG8_SA(0, 0), a2, voffA);
            PG8_WAIT_V(8); PG8_WAIT_L(0); PG8_BAR; PG8_MMA(1, 0, At, B0); PG8_MMA(1, 1, At, B1); PG8_BAR; PG8_SCHED;
            PG8_LDB(B0, 1, 0); PG8_LDB(B1, 1, 1); PG8_SCHED; PG8_LDA(At, 1, 0); PG8_STAGE(PG8_SA(0, 1), a2 + hstep, voffA);
            PG8_WAIT_V(8); PG8_WAIT_L(0); PG8_BAR; PG8_MMA(0, 0, At, B0); PG8_MMA(0, 1, At, B1); PG8_BAR; PG8_SCHED;
            PG8_LDA(At, 1, 1); PG8_STAGE(PG8_SB(1, 0), b3, voffB); PG8_STAGE(PG8_SB(1, 1), b3 + hstep, voffB); PG8_STAGE(PG8_SA(1, 0), a3, voffA);
            PG8_WAIT_V(8); PG8_WAIT_L(0); PG8_BAR; PG8_MMA(1, 0, At, B0); PG8_MMA(1, 1, At, B1); PG8_BAR; PG8_SCHED;
            } else {
            PG8_LDB(B0, 0, 0); PG8_SCHED; PG8_LDA(At, 0, 0); PG8_STAGE(PG8_SA(1, 1), a1 + hstep, voffA);
            PG8_WAIT_L(8); PG8_BAR; PG8_WAIT_L(0); PG8_MMA(0, 0, At, B0); PG8_BAR; PG8_SCHED;
            PG8_LDB(B1, 0, 1); PG8_STAGE(PG8_SB(0, 0), b2, voffB);
            PG8_BAR; PG8_WAIT_L(0); PG8_MMA(0, 1, At, B1); PG8_BAR;
            PG8_LDA(At, 0, 1); PG8_STAGE(PG8_SA(0, 0), a2, voffA);
            PG8_BAR; PG8_WAIT_L(0); PG8_MMA(1, 0, At, B0); PG8_BAR; PG8_SCHED;
            PG8_STAGE(PG8_SB(0, 1), b2 + hstep, voffB);
            PG8_WAIT_V(6); PG8_BAR; PG8_MMA(1, 1, At, B1); PG8_BAR;
            PG8_LDB(B0, 1, 0); PG8_SCHED; PG8_LDA(At, 1, 0); PG8_STAGE(PG8_SA(0, 1), a2 + hstep, voffA);
            PG8_WAIT_L(8); PG8_BAR; PG8_WAIT_L(0); PG8_MMA(0, 0, At, B0); PG8_BAR; PG8_SCHED;
            PG8_LDB(B1, 1, 1); PG8_STAGE(PG8_SB(1, 0), b3, voffB);
            PG8_BAR; PG8_WAIT_L(0); PG8_MMA(0, 1, At, B1); PG8_BAR;
            PG8_LDA(At, 1, 1); PG8_STAGE(PG8_SA(1, 0), a3, voffA);
            PG8_BAR; PG8_WAIT_L(0); PG8_MMA(1, 0, At, B0); PG8_BAR; PG8_SCHED;
            PG8_STAGE(PG8_SB(1, 1), b3 + hstep, voffB);
            PG8_WAIT_V(6); PG8_BAR; PG8_MMA(1, 1, At, B1); PG8_BAR;
            }
        }
        if constexpr (ALIGN_EPI) { if (wr == 0) PG8_BAR; }
        if constexpr (!Epi::AFTER_DRAIN) { E(acc, cur, wr, wc, fr, fq); S.done(cur); }
        if (!has_next) break;
#pragma unroll
        for (int a = 0; a < 2; ++a)
#pragma unroll
            for (int b = 0; b < 2; ++b)
#pragma unroll
                for (int m = 0; m < 4; ++m)
#pragma unroll
                    for (int n = 0; n < 2; ++n) acc[a][b][m][n] = (f32x4){0.f, 0.f, 0.f, 0.f};
        cur = nxt; cA = nA; cB = nB; ++ui;
        if constexpr (ALIGN_EPI) { if (wr == 1) PG8_BAR; }
    }
    PG8_WAIT_V(0);
    if constexpr (!ALIGN_EPI) { if (wr == 0) PG8_BAR; }
    PG8_BAR;
    if constexpr (Epi::AFTER_DRAIN) { E.fused(acc, cur, wr, wc, fr, fq, lds, wid, lane); S.done(cur); }
#undef PG8_SA
#undef PG8_SB
#undef PG8_STAGE
#undef PG8_LDA
#undef PG8_LDB
#undef PG8_MMA
#undef PG8_WAIT_V
#undef PG8_WAIT_L
#undef PG8_BAR
#undef PG8_SCHED
}
}

#define LAS __attribute__((address_space(3)))
typedef unsigned short bf16;
typedef float f32x4 __attribute__((ext_vector_type(4)));
typedef short bf16x8 __attribute__((ext_vector_type(8)));
typedef unsigned u32x4 __attribute__((ext_vector_type(4)));
typedef unsigned u32x2 __attribute__((ext_vector_type(2)));
using pg8::cvtpk;

#ifndef KN_NORM
#define KN_NORM 1
#endif
#ifndef KN_UP
#define KN_UP 1
#endif
#ifndef KN_PROJ
#define KN_PROJ 1
#endif
#ifndef KN_ATT
#define KN_ATT 1
#endif
#ifndef KN_CONV
#define KN_CONV 1
#endif
#ifndef KN_RES0
#define KN_RES0 1
#endif
#ifndef KN_SYNC
#define KN_SYNC 0
#endif
constexpr int NWAVES = 8;
constexpr int BATCH = 8, SEQ = 8192, D = 1024, DFF = 2816, NPROJ = 3072, M = BATCH * SEQ;
constexpr int NMOD = 9216;
constexpr float EPS = 1e-6f;
constexpr float L2E = 1.4426950408889634f;
constexpr int LDS_BYTES = 147456;

constexpr size_t MiB = 1u << 20;
constexpr size_t WS_MOD = 0;
constexpr size_t MOD_BYTES = (size_t)BATCH * NMOD * 4;
constexpr size_t WS_BAR = 512 * 1024;
constexpr size_t WS_SSQ = 576 * 1024;
constexpr size_t CTL_ZERO_BYTES = 1 * MiB;
constexpr size_t WS_W1IN = 2 * MiB, WS_W1OUT = 13 * MiB, WS_WIN = 19 * MiB, WS_WOUT = 25 * MiB, WS_W2IN = 27 * MiB, WS_W2OUT = 38 * MiB;
constexpr size_t WS_XN = 64 * MiB;
constexpr size_t WS_ACT = 192 * MiB;
constexpr size_t WS_XS = 576 * MiB;
constexpr size_t WS_END = 704 * MiB;

__device__ __forceinline__ int fresh_lane() { int z = 0; asm volatile("" : "+v"(z)); return (int)__builtin_amdgcn_mbcnt_hi(~0u, __builtin_amdgcn_mbcnt_lo(~0u, (unsigned)z)); }
__device__ __forceinline__ int launder_s(int v) { asm volatile("" : "+s"(v)); return v; }
__device__ __forceinline__ int launder_v(int v) { asm volatile("" : "+v"(v)); return v; }
__device__ __forceinline__ int opaque_zero() { int z = 0; asm volatile("" : "+s"(z)); return z; }
template <class T> __device__ __forceinline__ T* launder(T* p) { asm volatile("" : "+s"(p)); return p; }
#define GAS __attribute__((address_space(1)))
template <class T> __device__ __forceinline__ GAS T* gp(T* p) { return (GAS T*)p; }
__device__ __forceinline__ float wave_sum(float v) {
#pragma unroll
    for (int o = 1; o < 64; o <<= 1) v += __shfl_xor(v, o);
    return v;
}
__device__ __forceinline__ float wave_max(float v) {
#pragma unroll
    for (int o = 1; o < 64; o <<= 1) v = fmaxf(v, __shfl_xor(v, o));
    return v;
}
__device__ __forceinline__ float bf_lo(unsigned w) { return __uint_as_float(w << 16); }
__device__ __forceinline__ float bf_hi(unsigned w) { return __uint_as_float(w & 0xffff0000u); }

__device__ __forceinline__ void transpose_item(const float* W, int K, int N, bf16* WT, int k0, int n0, int drow0, LAS float* scr, int lane, const float* kscale = nullptr) {
    {
        f32x4 w[8]; const int c4 = lane & 7, r8 = lane >> 3;
#pragma unroll
        for (int i = 0; i < 8; ++i) w[i] = *(const GAS f32x4*)(W + (size_t)(k0 + 8 * i + r8) * N + n0 + 4 * c4);
#pragma unroll
        for (int i = 0; i < 8; ++i) { const int kk = 8 * i + r8; f32x4 v = w[i]; if (kscale) v = v * ((const GAS float*)kscale)[k0 + kk];
            LAS float* d = scr + kk * 33 + 4 * c4; d[0] = v[0]; d[1] = v[1]; d[2] = v[2]; d[3] = v[3]; }
    }
    asm volatile("s_waitcnt lgkmcnt(0)" ::: "memory");
    const int c = lane & 7;
#pragma unroll
    for (int j = 0; j < 4; ++j) { const int n = (lane >> 3) + 8 * j; const LAS float* s = scr + (8 * c) * 33 + n;
        u32x4 o; o.x = cvtpk(s[0 * 33], s[1 * 33]); o.y = cvtpk(s[2 * 33], s[3 * 33]); o.z = cvtpk(s[4 * 33], s[5 * 33]); o.w = cvtpk(s[6 * 33], s[7 * 33]);
        *(GAS u32x4*)(WT + (size_t)(drow0 + n) * K + k0 + 8 * c) = o; }
    asm volatile("s_waitcnt lgkmcnt(0)" ::: "memory");
}
__device__ __forceinline__ int drow_plain(int n0) { return n0; }
__device__ __forceinline__ int drow_swiglu(int n0) { return n0 < DFF ? (n0 >> 7) * 256 + (n0 & 127) : ((n0 - DFF) >> 7) * 256 + 128 + ((n0 - DFF) & 127); }
__device__ __forceinline__ int drow_proj(int n0) { const int L = n0 & 255; return (n0 & ~255) + 128 * ((L >> 5) & 1) + 32 * (L >> 6); }

template <int R> __device__ __forceinline__ void norm_rows_bf16(const float* x, bf16* o, int m0, int rstride, const float* g, const float* shift, const float* scale, int lane) {
    f32x4 v[R][4]; float s[R];
#pragma unroll
    for (int r = 0; r < R; ++r) { const GAS f32x4* xr = (const GAS f32x4*)(x + (size_t)(m0 + r * rstride) * D) + lane;
#pragma unroll
        for (int j = 0; j < 4; ++j) v[r][j] = xr[64 * j]; }
#pragma unroll
    for (int r = 0; r < R; ++r) { s[r] = 0.f;
#pragma unroll
        for (int j = 0; j < 4; ++j) s[r] += (v[r][j].x * v[r][j].x + v[r][j].y * v[r][j].y) + (v[r][j].z * v[r][j].z + v[r][j].w * v[r][j].w); }
#pragma unroll
    for (int of = 1; of < 64; of <<= 1) {
#pragma unroll
        for (int r = 0; r < R; ++r) s[r] += __shfl_xor(s[r], of); }
#pragma unroll
    for (int j = 0; j < 4; ++j) {
        const f32x4 gg = ((const GAS f32x4*)g)[lane + 64 * j], sh = ((const GAS f32x4*)shift)[lane + 64 * j], sc = ((const GAS f32x4*)scale)[lane + 64 * j];
        const f32x4 gs = gg * (sc + 1.0f);
#pragma unroll
        for (int r = 0; r < R; ++r) {
            const float rstd = 1.0f / sqrtf(s[r] * (1.0f / D) + EPS);
            const f32x4 y = v[r][j] * rstd * gs + sh;
            u32x2 w; w.x = cvtpk(y.x, y.y); w.y = cvtpk(y.z, y.w); ((GAS u32x2*)(o + (size_t)(m0 + r * rstride) * D) + lane)[64 * j] = w;
        }
    }
}
template <int R> __device__ __forceinline__ void final_norm_rows(float* x, int m0, int rstride, const float* g, int lane) {
    f32x4 v[R][4]; float s[R];
#pragma unroll
    for (int r = 0; r < R; ++r) { const GAS f32x4* xr = (const GAS f32x4*)(x + (size_t)(m0 + r * rstride) * D) + lane;
#pragma unroll
        for (int j = 0; j < 4; ++j) v[r][j] = xr[64 * j]; }
#pragma unroll
    for (int r = 0; r < R; ++r) { s[r] = 0.f;
#pragma unroll
        for (int j = 0; j < 4; ++j) s[r] += (v[r][j].x * v[r][j].x + v[r][j].y * v[r][j].y) + (v[r][j].z * v[r][j].z + v[r][j].w * v[r][j].w); }
#pragma unroll
    for (int of = 1; of < 64; of <<= 1) {
#pragma unroll
        for (int r = 0; r < R; ++r) s[r] += __shfl_xor(s[r], of); }
#pragma unroll
    for (int j = 0; j < 4; ++j) {
        const f32x4 gg = ((const GAS f32x4*)g)[lane + 64 * j];
#pragma unroll
        for (int r = 0; r < R; ++r) {
            const float rstd = 1.0f / sqrtf(s[r] * (1.0f / D) + EPS);
            ((GAS f32x4*)(x + (size_t)(m0 + r * rstride) * D) + lane)[64 * j] = v[r][j] * rstd * gg;
        }
    }
}

__device__ __forceinline__ f32x4 unpack_lo4(const u32x4 w) { return (f32x4){bf_lo(w.x), bf_hi(w.x), bf_lo(w.y), bf_hi(w.y)}; }
__device__ __forceinline__ f32x4 unpack_hi4(const u32x4 w) { return (f32x4){bf_lo(w.z), bf_hi(w.z), bf_lo(w.w), bf_hi(w.w)}; }
__device__ __forceinline__ float sumsq8(const u32x4 w) { const f32x4 a = unpack_lo4(w), b = unpack_hi4(w); return ((a.x * a.x + a.y * a.y) + (a.z * a.z + a.w * a.w)) + ((b.x * b.x + b.y * b.y) + (b.z * b.z + b.w * b.w)); }
template <int R> __device__ __forceinline__ void norm_rows_bf16in(const bf16* x, bf16* o, int m0, int rstride, const float* g, const float* shift, const float* scale, int lane) {
    u32x4 v[R][2]; float s[R];
#pragma unroll
    for (int r = 0; r < R; ++r) { const GAS u32x4* xr = (const GAS u32x4*)(x + (size_t)(m0 + r * rstride) * D) + lane; v[r][0] = xr[0]; v[r][1] = xr[64]; }
#pragma unroll
    for (int r = 0; r < R; ++r) { s[r] = 0.f;
#pragma unroll
        for (int j = 0; j < 2; ++j) s[r] += sumsq8(v[r][j]); }
#pragma unroll
    for (int of = 1; of < 64; of <<= 1) {
#pragma unroll
        for (int r = 0; r < R; ++r) s[r] += __shfl_xor(s[r], of); }
#pragma unroll
    for (int j = 0; j < 2; ++j) {
        const int i4 = 2 * (lane + 64 * j);
        const f32x4 g0 = ((const GAS f32x4*)g)[i4], g1 = ((const GAS f32x4*)g)[i4 + 1], h0 = ((const GAS f32x4*)shift)[i4], h1 = ((const GAS f32x4*)shift)[i4 + 1], c0 = ((const GAS f32x4*)scale)[i4], c1 = ((const GAS f32x4*)scale)[i4 + 1];
        const f32x4 gs0 = g0 * (c0 + 1.0f), gs1 = g1 * (c1 + 1.0f);
#pragma unroll
        for (int r = 0; r < R; ++r) {
            const float rstd = 1.0f / sqrtf(s[r] * (1.0f / D) + EPS);
            const f32x4 y0 = unpack_lo4(v[r][j]) * rstd * gs0 + h0, y1 = unpack_hi4(v[r][j]) * rstd * gs1 + h1;
            u32x4 w; w.x = cvtpk(y0.x, y0.y); w.y = cvtpk(y0.z, y0.w); w.z = cvtpk(y1.x, y1.y); w.w = cvtpk(y1.z, y1.w);
            ((GAS u32x4*)(o + (size_t)(m0 + r * rstride) * D) + lane)[64 * j] = w;
        }
    }
}
template <int R> __device__ __forceinline__ void final_norm_rows_bf16in(const bf16* x, float* o, int m0, int rstride, const float* g, int lane) {
    u32x4 v[R][2]; float s[R];
#pragma unroll
    for (int r = 0; r < R; ++r) { const GAS u32x4* xr = (const GAS u32x4*)(x + (size_t)(m0 + r * rstride) * D) + lane; v[r][0] = xr[0]; v[r][1] = xr[64]; }
#pragma unroll
    for (int r = 0; r < R; ++r) { s[r] = 0.f;
#pragma unroll
        for (int j = 0; j < 2; ++j) s[r] += sumsq8(v[r][j]); }
#pragma unroll
    for (int of = 1; of < 64; of <<= 1) {
#pragma unroll
        for (int r = 0; r < R; ++r) s[r] += __shfl_xor(s[r], of); }
#pragma unroll
    for (int j = 0; j < 2; ++j) {
        const int i4 = 2 * (lane + 64 * j);
        const f32x4 g0 = ((const GAS f32x4*)g)[i4], g1 = ((const GAS f32x4*)g)[i4 + 1];
#pragma unroll
        for (int r = 0; r < R; ++r) {
            const float rstd = 1.0f / sqrtf(s[r] * (1.0f / D) + EPS);
            GAS f32x4* op = (GAS f32x4*)(o + (size_t)(m0 + r * rstride) * D) + i4;
            op[0] = unpack_lo4(v[r][j]) * rstd * g0; op[1] = unpack_hi4(v[r][j]) * rstd * g1;
        }
    }
}

__device__ __forceinline__ void mod_item(const float* c, const float* w_ada, const float* b_ada, float* mod, int item, int lane) {
    const int ks = item / 36, nb = item % 36, k0 = ks * 64, n0 = nb * 256 + 4 * lane;
    float sv[BATCH];
#pragma unroll
    for (int b = 0; b < BATCH; ++b) { const float x = c[b * D + k0 + lane]; sv[b] = x * __builtin_amdgcn_rcpf(1.0f + __builtin_amdgcn_exp2f(-L2E * x)); }
    f32x4 acc[BATCH];
#pragma unroll
    for (int b = 0; b < BATCH; ++b) acc[b] = (f32x4){0.f, 0.f, 0.f, 0.f};
    const float* wp = w_ada + (size_t)k0 * NMOD + n0;
#pragma unroll 8
    for (int kk = 0; kk < 64; ++kk) {
        const f32x4 w = *(const f32x4*)(wp + (size_t)kk * NMOD);
#pragma unroll
        for (int b = 0; b < BATCH; ++b) { const float s = __builtin_bit_cast(float, __builtin_amdgcn_readlane(__builtin_bit_cast(int, sv[b]), kk)); acc[b] += w * s; }
    }
    if (ks == 0) { const f32x4 bb = *(const f32x4*)(b_ada + n0);
#pragma unroll
        for (int b = 0; b < BATCH; ++b) acc[b] += bb; }
#pragma unroll
    for (int b = 0; b < BATCH; ++b) { float* mp = mod + b * NMOD + n0; atomicAdd(mp, acc[b].x); atomicAdd(mp + 1, acc[b].y); atomicAdd(mp + 2, acc[b].z); atomicAdd(mp + 3, acc[b].w); }
}

constexpr int KP = 144;
constexpr int AT_TILE = 64 * KP, AT_STAGE = 4 * AT_TILE;
constexpr int AT_TB = 2 * AT_STAGE;
static_assert(AT_TB + 257 * 4 <= 131072, "attention LDS map");

__device__ __forceinline__ void attn_bias_table(LAS unsigned char* lds, const float* relb, const float* gqn, const float* gkn, int h, int lane, int tid) {
    LAS float* tb = (LAS float*)(lds + AT_TB);
    {
        const float mq = wave_max(fabsf(gp(gqn)[lane])), mk = wave_max(fabsf(gp(gkn)[lane]));
        float bm = -3.0e38f;
#pragma unroll
        for (int j = 0; j < 5; ++j) { const int idx = lane + 64 * j; bm = fmaxf(bm, idx < 257 ? gp(relb)[h * 257 + idx] : -3.0e38f); }
        bm = wave_max(bm);
        const float B = L2E * (8.1f * mq * mk + bm);
        if (tid < 257) tb[tid] = L2E * gp(relb)[h * 257 + tid] - B;
    }
}
__device__ __forceinline__ void attn_unit(LAS unsigned char* lds, const bf16* PROJ, bf16* YMIX, float* ssq, const float* relb, const float* gqn, const float* gkn,
                                          int b, int h, int c0, int wave, int lane_in, int tid_in) {
    const int lane = launder_v(lane_in), tid = launder_v(tid_in); wave = launder_s(wave);
    const int fr = lane & 15, fq = lane >> 4;
    const LAS float* tb = (const LAS float*)(lds + AT_TB);
    const int r4 = wave & 3, par = wave >> 2;
    const size_t tok0 = (size_t)b * SEQ + (size_t)(c0 + par) * 64 + 16 * r4;
    bf16x8 qf[4][2];
#pragma unroll
    for (int nq = 0; nq < 4; ++nq)
#pragma unroll
        for (int kk = 0; kk < 2; ++kk) qf[nq][kk] = *(const GAS bf16x8*)(PROJ + (tok0 + 128 * nq + fr) * NPROJ + h * 64 + 32 * kk + 8 * fq);
    f32x4 O[4][4], L[4];
    const bf16x8 ones8 = {(short)0x3f80, (short)0x3f80, (short)0x3f80, (short)0x3f80, (short)0x3f80, (short)0x3f80, (short)0x3f80, (short)0x3f80};
#pragma unroll
    for (int md = 0; md < 4; ++md)
#pragma unroll
        for (int nq = 0; nq < 4; ++nq) O[md][nq] = (f32x4){0.f, 0.f, 0.f, 0.f};
#pragma unroll
    for (int nq = 0; nq < 4; ++nq) L[nq] = (f32x4){0.f, 0.f, 0.f, 0.f};
    const int j0 = (c0 == 0) ? 8 : 0;
    const int skey = tid >> 3, sd = (tid & 7) * 8;
    const bf16* Kg = PROJ + ((size_t)b * SEQ + (size_t)((c0 - 8 + j0) * 64 + skey)) * NPROJ + 512 + h * 64 + sd;
    const LAS unsigned char* const rd0 = lds;
    LAS unsigned char* const wr0 = lds + skey * KP + sd * 2;
    const bf16* Kg2 = Kg + (size_t)64 * NPROJ;
    u32x4 pa[4], pb[4];
#define AT_GLOAD(dst) do { asm volatile("global_load_dwordx4 %0, %1, off" : "=&v"(dst[0]) : "v"(Kg) : "memory"); asm volatile("global_load_dwordx4 %0, %1, off offset:1024" : "=&v"(dst[1]) : "v"(Kg) : "memory"); \
        asm volatile("global_load_dwordx4 %0, %1, off" : "=&v"(dst[2]) : "v"(Kg2) : "memory"); asm volatile("global_load_dwordx4 %0, %1, off offset:1024" : "=&v"(dst[3]) : "v"(Kg2) : "memory"); \
        Kg += (size_t)128 * NPROJ; Kg2 += (size_t)128 * NPROJ; } while (0)
#define AT_WAIT4(src) asm volatile("s_waitcnt vmcnt(4)" : "+v"(src[0]), "+v"(src[1]), "+v"(src[2]), "+v"(src[3]) :: "memory")
#define AT_WAIT0(src) asm volatile("s_waitcnt vmcnt(0)" : "+v"(src[0]), "+v"(src[1]), "+v"(src[2]), "+v"(src[3]) :: "memory")
#define AT_STORE(src, stage) do { _Pragma("unroll") for (int q_ = 0; q_ < 4; ++q_) *(LAS u32x4*)(wr0 + (stage) * AT_STAGE + q_ * AT_TILE) = src[q_]; } while (0)
    asm volatile("s_waitcnt vmcnt(0)" ::: "memory");
    AT_GLOAD(pa); AT_WAIT0(pa); AT_STORE(pa, 0);
    AT_GLOAD(pb);
    AT_GLOAD(pa);
#define AT_QK(S, nq) do { _Pragma("unroll") for (int mk = 0; mk < 2; ++mk) _Pragma("unroll") for (int kk = 0; kk < 2; ++kk) S[mk] = __builtin_amdgcn_mfma_f32_16x16x32_bf16(kf[mk][kk], qf[nq][kk], S[mk], 0, 0, 0); } while (0)
#define AT_EXP(S, pb, nq) do { float p[8]; _Pragma("unroll") for (int i = 0; i < 4; ++i) { p[i] = __builtin_amdgcn_exp2f(S[0][i]); p[4 + i] = __builtin_amdgcn_exp2f(S[1][i]); } \
        const u32x4 pk = {cvtpk(p[0], p[1]), cvtpk(p[2], p[3]), cvtpk(p[4], p[5]), cvtpk(p[6], p[7])}; pb = __builtin_bit_cast(bf16x8, pk); } while (0)
#define AT_PV(pb, nq) do { _Pragma("unroll") for (int md = 0; md < 4; ++md) O[md][nq] = __builtin_amdgcn_mfma_f32_16x16x32_bf16(vf[md], pb, O[md][nq], 0, 0, 0); \
        L[nq] = __builtin_amdgcn_mfma_f32_16x16x32_bf16(ones8, pb, L[nq], 0, 0, 0); } while (0)
#define AT_QK_C(S, nq) do { _Pragma("unroll") for (int mk = 0; mk < 2; ++mk) { S[mk] = __builtin_amdgcn_mfma_f32_16x16x32_bf16(kf[mk][0], qf[nq][0], c4v, 0, 0, 0); S[mk] = __builtin_amdgcn_mfma_f32_16x16x32_bf16(kf[mk][1], qf[nq][1], S[mk], 0, 0, 0); } } while (0)
#define AT_INIT_T(S, nq) do { _Pragma("unroll") for (int mk = 0; mk < 2; ++mk) { const int base = 64 * t + 32 * sub - 384 + 16 * mk + 4 * fq - 16 * r4 - fr; \
        _Pragma("unroll") for (int i = 0; i < 4; ++i) { const int idx = base + i; S[mk][i] = tb[idx > 0 ? idx : 0]; } } } while (0)
#define AT_STEP(j, soff) do { \
        const float c0v = tb[0]; const f32x4 c4v = {c0v, c0v, c0v, c0v}; \
        _Pragma("unroll") for (int sub = 0; sub < 2; ++sub) { \
            const LAS unsigned char* kb = rd0 + (soff) + sub * 32 * KP; const LAS unsigned char* vb = kb + AT_TILE; \
            bf16x8 kf[2][2], vf[4]; \
            _Pragma("unroll") for (int mk = 0; mk < 2; ++mk) _Pragma("unroll") for (int kk = 0; kk < 2; ++kk) kf[mk][kk] = *(const LAS bf16x8*)(kb + (16 * mk + fr) * KP + (32 * kk + 8 * fq) * 2); \
            _Pragma("unroll") for (int md = 0; md < 4; ++md) { \
                const v4i16_t lo = __builtin_amdgcn_ds_read_tr16_b64_v4i16((LAS v4i16_t*)(vb + (4 * fq + (fr >> 2)) * KP + (16 * md + 4 * (fr & 3)) * 2)); \
                const v4i16_t hi = __builtin_amdgcn_ds_read_tr16_b64_v4i16((LAS v4i16_t*)(vb + (16 + 4 * fq + (fr >> 2)) * KP + (16 * md + 4 * (fr & 3)) * 2)); \
                vf[md] = (bf16x8){lo[0], lo[1], lo[2], lo[3], hi[0], hi[1], hi[2], hi[3]}; } \
            _Pragma("unroll") for (int nq = 0; nq < 4; ++nq) { \
                const int t = (j) - 2 * nq - par; \
                if (t >= 0 && t <= 8) { f32x4 S[2]; bf16x8 pb; \
                    if (t < 6) { AT_QK_C(S, nq); } else { AT_INIT_T(S, nq); AT_QK(S, nq); } \
                    AT_EXP(S, pb, nq); AT_PV(pb, nq); } \
            } \
        } } while (0)
    typedef short v4i16_t __attribute__((ext_vector_type(4)));
    for (int jp = j0 >> 1; jp < 8; jp += 2) {
        __syncthreads();
        AT_STEP(2 * jp, 0);
        AT_STEP(2 * jp + 1, 2 * AT_TILE);
        if (jp + 2 < 8) AT_WAIT4(pb); else AT_WAIT0(pb);
        AT_STORE(pb, 1);
        if (jp + 3 < 8) AT_GLOAD(pb);
        __syncthreads();
        AT_STEP(2 * jp + 2, AT_STAGE);
        AT_STEP(2 * jp + 3, AT_STAGE + 2 * AT_TILE);
        if (jp + 2 < 8) {
            if (jp + 3 < 8) AT_WAIT4(pa); else AT_WAIT0(pa);
            AT_STORE(pa, 0);
            if (jp + 4 < 8) AT_GLOAD(pa);
        }
    }
#undef AT_GLOAD
#undef AT_WAIT4
#undef AT_WAIT0
#undef AT_LOAD
#undef AT_STORE
#undef AT_STEP
#undef AT_BODY
#undef AT_QK
#undef AT_EXP
#undef AT_PV
#undef AT_QK_C
#undef AT_INIT_T
    const int lane3 = launder_v(lane_in), fr3 = lane3 & 15, fq3 = lane3 >> 4;
#pragma unroll
    for (int nq = 0; nq < 4; ++nq) {
        const float inv = 1.0f / L[nq][0];
        float ss = 0.f;
#pragma unroll
        for (int md = 0; md < 4; ++md) { O[md][nq] = O[md][nq] * inv; const f32x4 x = O[md][nq]; ss += (x[0] * x[0] + x[1] * x[1]) + (x[2] * x[2] + x[3] * x[3]); }
        ss += __shfl_xor(ss, 16); ss += __shfl_xor(ss, 32);
        if (fq3 == 0) (void)__hip_atomic_fetch_add(gp(ssq) + tok0 + 128 * nq + fr3, ss, __ATOMIC_RELAXED, __HIP_MEMORY_SCOPE_AGENT);
#pragma unroll
        for (int md = 0; md < 4; ++md) {
            const f32x4 y = O[md][nq];
            u32x2 w; w.x = cvtpk(y[0], y[1]); w.y = cvtpk(y[2], y[3]);
            *(GAS u32x2*)(YMIX + (tok0 + 128 * nq + fr3) * D + h * 64 + 16 * md + 4 * fq3) = w;
        }
    }
    __syncthreads();
}

__device__ __forceinline__ void conv_unit(const bf16* PROJ, bf16* YMIX, const float* w_conv, const float* b_conv, const float* g_conv, int b, int c, int wave, int lane_in) {
    {
        const int lane2 = launder_v(lane_in); wave = launder_s(wave);
        const int ch0 = 8 * lane2;
        float w0[8], w1[8], w2[8], bc[8], gc[8];
#pragma unroll
        for (int e = 0; e < 8; ++e) { w0[e] = gp(w_conv)[ch0 + e]; w1[e] = gp(w_conv)[512 + ch0 + e]; w2[e] = gp(w_conv)[1024 + ch0 + e]; bc[e] = gp(b_conv)[ch0 + e]; gc[e] = gp(g_conv)[ch0 + e]; }
        const int s0 = c * 64 + 8 * wave;
        const bf16* rowp = PROJ + ((size_t)b * SEQ + s0) * NPROJ + ch0;
        u32x4 xa[10], ga[10], gb[8];
#pragma unroll
        for (int r = 0; r < 10; ++r) { if (r >= 2 || s0 >= 2) { xa[r] = *(const GAS u32x4*)(rowp + (r - 2) * NPROJ + 1536); ga[r] = *(const GAS u32x4*)(rowp + (r - 2) * NPROJ + 2560); }
            else { xa[r] = (u32x4){0u, 0u, 0u, 0u}; ga[r] = xa[r]; } }
#pragma unroll
        for (int r = 0; r < 8; ++r) gb[r] = *(const GAS u32x4*)(rowp + r * NPROJ + 2048);
#define CV_U(dst, xv, gv) do { dst[0] = bf_lo(xv.x) * bf_lo(gv.x); dst[1] = bf_hi(xv.x) * bf_hi(gv.x); dst[2] = bf_lo(xv.y) * bf_lo(gv.y); dst[3] = bf_hi(xv.y) * bf_hi(gv.y); \
        dst[4] = bf_lo(xv.z) * bf_lo(gv.z); dst[5] = bf_hi(xv.z) * bf_hi(gv.z); dst[6] = bf_lo(xv.w) * bf_lo(gv.w); dst[7] = bf_hi(xv.w) * bf_hi(gv.w); } while (0)
        float u0[8], u1[8];
        CV_U(u0, xa[0], ga[0]); CV_U(u1, xa[1], ga[1]);
#pragma unroll
        for (int r = 0; r < 8; ++r) {
            float u2[8]; CV_U(u2, xa[r + 2], ga[r + 2]);
            const u32x4 gbv = gb[r];
            float gbf[8] = {bf_lo(gbv.x), bf_hi(gbv.x), bf_lo(gbv.y), bf_hi(gbv.y), bf_lo(gbv.z), bf_hi(gbv.z), bf_lo(gbv.w), bf_hi(gbv.w)};
            float y[8]; float ss = 0.f;
#pragma unroll
            for (int e = 0; e < 8; ++e) { y[e] = gbf[e] * (w0[e] * u0[e] + w1[e] * u1[e] + w2[e] * u2[e] + bc[e]); ss += y[e] * y[e]; }
            const float rstd = 1.0f / sqrtf(wave_sum(ss) * (1.0f / 512.0f) + EPS);
            u32x4 o;
            o.x = cvtpk(y[0] * rstd * gc[0], y[1] * rstd * gc[1]); o.y = cvtpk(y[2] * rstd * gc[2], y[3] * rstd * gc[3]);
            o.z = cvtpk(y[4] * rstd * gc[4], y[5] * rstd * gc[5]); o.w = cvtpk(y[6] * rstd * gc[6], y[7] * rstd * gc[7]);
            *(GAS u32x4*)(YMIX + ((size_t)b * SEQ + s0 + r) * D + 512 + ch0) = o;
#pragma unroll
            for (int e = 0; e < 8; ++e) { u0[e] = u1[e]; u1[e] = u2[e]; }
        }
#undef CV_U
    }
}

#define XB_TMO      128
#define XB_XCNT(j)  (256  + 64 * (j))
#define XB_XSUB(j)  (1280 + 64 * (j))
#define XB_XGEN(j)  (2304 + 64 * (j))
#define XB_TOP      3328
#define XB_TOPGEN   3392
#define XCD_BAR_WORDS 3456
#define XB_SPIN_CAP (1u << 18)

__device__ __forceinline__ unsigned xb_ld(unsigned* p)              { return __hip_atomic_load(p, __ATOMIC_RELAXED, __HIP_MEMORY_SCOPE_AGENT); }
__device__ __forceinline__ unsigned xb_add(unsigned* p, unsigned v) { return __hip_atomic_fetch_add(p, v, __ATOMIC_RELAXED, __HIP_MEMORY_SCOPE_AGENT); }
__device__ __forceinline__ unsigned xb_xcc_id() { return (unsigned)__builtin_amdgcn_s_getreg((3 << 11) | 20) & 0xFu; }
#define XB_SPIN(cond, bar) do { unsigned _sp = 0; while (cond) { __builtin_amdgcn_s_sleep(1); \
    if ((++_sp & 255u) == 0u) { if (xb_ld(&(bar)[XB_TMO])) break; if (_sp > XB_SPIN_CAP) { atomicAdd(&(bar)[XB_TMO], 1u); break; } } } } while (0)

struct XcdBarrier {
    unsigned* bar; unsigned x;
    volatile LAS unsigned* st;
};

__device__ __forceinline__ XcdBarrier xcd_barrier_post(unsigned* bar, volatile LAS unsigned* st) {
    XcdBarrier b; b.bar = bar; b.x = xb_xcc_id(); b.st = st;
    if (threadIdx.x == 0) (void)xb_add(&bar[XB_XCNT(b.x)], 1u);
    return b;
}
__device__ __forceinline__ void xcd_barrier_complete(unsigned* bar, unsigned x, unsigned& nloc, unsigned& nx) {
    const unsigned G = gridDim.x * gridDim.y * gridDim.z;
    unsigned sum, cnt, mine, sp = 0u;
    for (;;) {
        sum = 0u; cnt = 0u;
#pragma unroll
        for (unsigned j = 0; j < 16; ++j) { const unsigned c = xb_ld(&bar[XB_XCNT(j)]); sum += c; cnt += (c > 0u) ? 1u : 0u; }
        mine = xb_ld(&bar[XB_XCNT(x)]);
        if (sum == G) break;
        __builtin_amdgcn_s_sleep(1);
        if ((++sp & 255u) == 0u) { if (xb_ld(&bar[XB_TMO])) break; if (sp > XB_SPIN_CAP) { atomicAdd(&bar[XB_TMO], 1u); break; } }
    }
    nloc = mine > 0u ? mine : 1u; nx = cnt > 0u ? cnt : 1u;
}

__device__ __forceinline__ void xcd_barrier(const XcdBarrier& b_in, const bool is_t0) {
    XcdBarrier b = b_in; b.x = (unsigned)launder_s(__builtin_amdgcn_readfirstlane((int)b_in.x)); b.bar = launder(b_in.bar);
    asm volatile("s_waitcnt vmcnt(0)" ::: "memory");
    __syncthreads();
    if (is_t0) {
        unsigned* bar = b.bar;
        __builtin_amdgcn_s_waitcnt(0);
        unsigned nloc = b.st[0], nx = b.st[1];
        if (nloc == 0u) { xcd_barrier_complete(bar, b.x, nloc, nx); b.st[0] = nloc; b.st[1] = nx; }
        const unsigned old = xb_add(&bar[XB_XSUB(b.x)], 1u);
        const unsigned gen = old / nloc;
        if (old + 1u == (gen + 1u) * nloc) {
            __builtin_amdgcn_fence(__ATOMIC_RELEASE, "agent");
            asm volatile("s_waitcnt vmcnt(0)" ::: "memory");
            const unsigned og = xb_add(&bar[XB_TOP], 1u);
            const unsigned tg = og / nx;
            if (og + 1u == (tg + 1u) * nx) xb_add(&bar[XB_TOPGEN], 1u);
            else XB_SPIN(xb_ld(&bar[XB_TOPGEN]) == tg, bar);
            __builtin_amdgcn_fence(__ATOMIC_ACQUIRE, "agent");
            xb_add(&bar[XB_XGEN(b.x)], 1u);
            asm volatile("s_waitcnt vmcnt(0)" ::: "memory");
        } else {
            XB_SPIN(xb_ld(&bar[XB_XGEN(b.x)]) == gen, bar);
            __builtin_amdgcn_fence(__ATOMIC_ACQUIRE, "agent");
            asm volatile("s_waitcnt vmcnt(0)" ::: "memory");
        }
    }
    __syncthreads();
}

struct Args {
    const float *x, *c, *w_ada, *b_ada, *g_norm, *w_ffn1_in, *w_ffn1_out, *w_in, *q_norm_g, *k_norm_g, *rel_bias, *w_conv, *b_conv, *g_attn_out, *g_conv_out, *w_out, *w_ffn2_in, *w_ffn2_out, *g_final;
    float* out; unsigned char* ws;
    int rep_norm, rep_up, rep_proj, rep_att, rep_conv, rep_res0, rep_sync, pad;
};

__global__ void __launch_bounds__(NWAVES * 64, 2) fwd_megakernel(Args a_unused) {
#define KARG(f) (kargp[opaque_zero()].f)
    typedef const __attribute__((address_space(4))) Args* kargp_t;
    const kargp_t kargp = (kargp_t)__builtin_amdgcn_kernarg_segment_ptr();
    extern __shared__ __attribute__((aligned(16))) unsigned char lds_raw[];
    cg::grid_group grid = cg::this_grid();
    LAS unsigned char* lds = (LAS unsigned char*)lds_raw;
    const int wave = __builtin_amdgcn_readfirstlane((int)threadIdx.x >> 6);
#define FRESH_LANE() fresh_lane()
#define FRESH_TID() (launder_s(wave) * 64 + fresh_lane())
    constexpr int G = 256; const int bx = blockIdx.x;
    const int gw = bx * NWAVES + wave, NGW = G * NWAVES;
    unsigned char* ws = KARG(ws);
    float* mod = (float*)(ws + WS_MOD);
#define GRID_BAR() xcd_barrier(xbar, FRESH_TID() == 0)
    volatile LAS unsigned* bst = (volatile LAS unsigned*)(lds + 131072 + 64);
    { const int t0 = FRESH_TID(); if (t0 < 2) bst[t0] = 0u; }
    __syncthreads();
    const XcdBarrier xbar = xcd_barrier_post((unsigned*)(ws + WS_BAR), bst);

    {
        const int it = wave * G + bx;
        if (wave < 3 && it < 16 * 36) mod_item(KARG(c), KARG(w_ada), KARG(b_ada), mod, it, FRESH_LANE());
    }
    if (KARG(rep_sync) < 0) grid.sync();
    GRID_BAR();
    {
        constexpr int I_IN = (D / 64) * (2 * DFF / 32), I_OUT = (DFF / 64) * (D / 32), I_PROJ = (D / 64) * (NPROJ / 32), I_WO = (D / 64) * (D / 32);
        constexpr int NITEMS = 2 * I_IN + 2 * I_OUT + I_PROJ + I_WO;
        LAS float* scr = (LAS float*)(lds + wave * 16384); const int lane = FRESH_LANE();
        for (int it = gw; it < NITEMS; it += NGW) {
            int r = it;
            if (r < 2 * I_IN) { const int f = r >= I_IN; r -= f * I_IN; const int nblk = 2 * DFF / 32, kb = r / nblk, nb = r % nblk;
                transpose_item(f ? KARG(w_ffn2_in) : KARG(w_ffn1_in), D, 2 * DFF, (bf16*)(ws + (f ? WS_W2IN : WS_W1IN)), 64 * kb, 32 * nb, drow_swiglu(32 * nb), scr, lane); continue; } r -= 2 * I_IN;
            if (r < 2 * I_OUT) { const int f = r >= I_OUT; r -= f * I_OUT; const int nblk = D / 32, kb = r / nblk, nb = r % nblk;
                transpose_item(f ? KARG(w_ffn2_out) : KARG(w_ffn1_out), DFF, D, (bf16*)(ws + (f ? WS_W2OUT : WS_W1OUT)), 64 * kb, 32 * nb, drow_plain(32 * nb), scr, lane); continue; } r -= 2 * I_OUT;
            if (r < I_PROJ) { const int nblk = NPROJ / 32, kb = r / nblk, nb = r % nblk;
                transpose_item(KARG(w_in), D, NPROJ, (bf16*)(ws + WS_WIN), 64 * kb, 32 * nb, drow_proj(32 * nb), scr, lane); continue; } r -= I_PROJ;
            { const int nblk = D / 32, kb = r / nblk, nb = r % nblk;
                transpose_item(KARG(w_out), D, D, (bf16*)(ws + WS_WOUT), 64 * kb, 32 * nb, drow_plain(32 * nb), scr, lane, kb < 8 ? KARG(g_attn_out) : nullptr); }
        }
    }

    for (int step = 0; step < 3; ++step) {
        unsigned char* wsl = launder(ws);
        float* modl = (float*)(wsl + WS_MOD);
        {
            bf16* XNl = (bf16*)(wsl + WS_XN); const int ln = FRESH_LANE();
            for (int rep = 0; rep < KARG(rep_norm); ++rep) {
            if (step == 0) { const float* xin = launder(KARG(x));
                for (int it = 0, m = gw; it < M / (4 * NGW); ++it, m += 4 * NGW) {
                    const float* mb = modl + (m >> 13) * NMOD + step * 3072;
                    norm_rows_bf16<4>(xin, XNl, m, NGW, KARG(g_norm) + step * D, mb, mb + 1024, ln); }
            } else { const bf16* xs = (const bf16*)(wsl + WS_XS);
                for (int it = 0, m = gw; it < M / (4 * NGW); ++it, m += 4 * NGW) {
                    const float* mb = modl + (m >> 13) * NMOD + step * 3072;
                    norm_rows_bf16in<4>(xs, XNl, m, NGW, KARG(g_norm) + step * D, mb, mb + 1024, ln); }
            } }
        }
        GRID_BAR();
        const bf16* A2; const bf16* B2; int K2;
        if (step != 1) {
            unsigned char* w2 = launder(wsl);
            pg8::Gemm g{(const bf16*)(w2 + WS_XN), (const bf16*)(w2 + (step == 0 ? WS_W1IN : WS_W2IN)), M, 2 * DFF, D}; pg8::StaticOrder S; S.init(M, 2 * DFF, G, bx);
            pg8::EpiSwiglu E{(bf16*)(w2 + WS_ACT), DFF};
            for (int rep = 0; rep < KARG(rep_up); ++rep)
            pg8::gemm_phase<pg8::EpiSwiglu, pg8::StaticOrder, true, true>(lds, g, S, E, FRESH_TID());
            GRID_BAR();
            A2 = (const bf16*)(wsl + WS_ACT); B2 = (const bf16*)(wsl + (step == 0 ? WS_W1OUT : WS_W2OUT)); K2 = DFF;
        } else {
            {
                unsigned char* w2 = launder(wsl);
                pg8::Gemm g{(const bf16*)(w2 + WS_XN), (const bf16*)(w2 + WS_WIN), M, NPROJ, D}; pg8::StaticOrder S; S.init(M, NPROJ, G, bx);
                pg8::EpiProj E{(bf16*)(w2 + WS_ACT), KARG(q_norm_g), KARG(k_norm_g)};
                for (int rep = 0; rep < KARG(rep_proj); ++rep)
                pg8::gemm_phase<pg8::EpiProj, pg8::StaticOrder, true, true>(lds, g, S, E, FRESH_TID());
            }
            GRID_BAR();
            {
                unsigned char* w2 = launder(wsl); const int ln = FRESH_LANE();
                const int vcu = (G % 8 == 0) ? (bx % 8) * (G / 8) + bx / 8 : bx;
                float* ssq = (float*)(w2 + WS_SSQ);
                attn_bias_table(lds, KARG(rel_bias), KARG(q_norm_g), KARG(k_norm_g), ((vcu * 4) >> 4) & 7, FRESH_LANE(), FRESH_TID());
                for (int rep = 0; rep < KARG(rep_att); ++rep)
                for (int j = 0; j < 4; ++j) {
                    const int uu = vcu * 4 + j;
                    attn_unit(lds, (const bf16*)(w2 + WS_ACT), (bf16*)(w2 + WS_XN), rep == 0 ? ssq : ssq + M, KARG(rel_bias), KARG(q_norm_g), KARG(k_norm_g), uu >> 7, (uu >> 4) & 7, 8 * (uu & 15), wave, FRESH_LANE(), FRESH_TID());
                }
                for (int rep = 0; rep < KARG(rep_conv); ++rep)
                for (int uu = vcu * 4; uu < vcu * 4 + 4; ++uu)
                    conv_unit((const bf16*)(w2 + WS_ACT), (bf16*)(w2 + WS_XN), KARG(w_conv), KARG(b_conv), KARG(g_conv_out), uu >> 7, uu & 127, wave, FRESH_LANE());
            }
            GRID_BAR();
            A2 = (const bf16*)(wsl + WS_XN); B2 = (const bf16*)(wsl + WS_WOUT); K2 = D;
        }
        {
            pg8::Gemm g{launder(A2), launder(B2), M, D, K2}; pg8::StaticOrder S; S.init(M, D, G, bx);
            pg8::EpiResid E{launder(KARG(x)), (bf16*)(wsl + WS_XS), launder(modl), (const float*)(wsl + WS_SSQ), step, step == 1 ? 8 : -1};
            for (int rep = 0; rep < (step == 0 ? KARG(rep_res0) : 1); ++rep)
            pg8::gemm_phase<pg8::EpiResid, pg8::StaticOrder, true, true>(lds, g, S, E, FRESH_TID());
        }
        GRID_BAR();
        for (int rep = 0; rep < KARG(rep_sync); ++rep) GRID_BAR();
    }
    { float* outp = launder(KARG(out)); const bf16* xs = (const bf16*)(launder(ws) + WS_XS); const int ln = FRESH_LANE(); for (int it = 0, m = gw; it < M / (4 * NGW); ++it, m += 4 * NGW) final_norm_rows_bf16in<4>(xs, outp, m, NGW, KARG(g_final), ln); }
}

extern "C" void kernel_launch(void* const* d_in, const int* in_sizes, int n_in, void* d_out, int out_size, void* d_ws, size_t ws_size, hipStream_t stream) {
    static int grid = 0;
    if (grid == 0) {
        if (n_in != 19 || out_size != M * D || ws_size < WS_END) { fprintf(stderr, "kernel_launch: unexpected shapes (n_in %d out %d ws %zu)\n", n_in, out_size, ws_size); grid = -1; return; }
        int dev = 0, cus = 0, per_cu = 0;
        (void)hipGetDevice(&dev);
        (void)hipDeviceGetAttribute(&cus, hipDeviceAttributeMultiprocessorCount, dev);
        if (hipFuncSetAttribute((const void*)fwd_megakernel, hipFuncAttributeMaxDynamicSharedMemorySize, LDS_BYTES) != hipSuccess) { fprintf(stderr, "kernel_launch: hipFuncSetAttribute failed\n"); grid = -1; return; }
        if (hipOccupancyMaxActiveBlocksPerMultiprocessor(&per_cu, (const void*)fwd_megakernel, NWAVES * 64, LDS_BYTES) != hipSuccess || per_cu < 1) { fprintf(stderr, "kernel_launch: occupancy query says %d\n", per_cu); per_cu = 1; }
        (void)hipGetLastError();
        grid = cus * per_cu;
        if (grid > 256) grid = 256;
        if (grid != 256) { fprintf(stderr, "kernel_launch: this kernel is built for a 256-workgroup grid, got %d; nothing launched\n", grid); grid = -1; return; }
        fprintf(stderr, "kernel_launch: grid %d (cus %d per_cu %d)\n", grid, cus, per_cu);
    }
    if (grid < 0) return;
    (void)hipMemsetAsync((char*)d_ws + WS_MOD, 0, CTL_ZERO_BYTES, stream);
    Args a{};
    const float** ap = (const float**)&a;
    for (int i = 0; i < 19; ++i) ap[i] = (const float*)d_in[i];
    a.out = (float*)d_out; a.ws = (unsigned char*)d_ws;
    a.rep_norm = KN_NORM; a.rep_up = KN_UP; a.rep_proj = KN_PROJ; a.rep_att = KN_ATT; a.rep_conv = KN_CONV; a.rep_res0 = KN_RES0; a.rep_sync = KN_SYNC; a.pad = 0;
    void* args[] = {&a};
    hipError_t e = hipLaunchCooperativeKernel((const void*)fwd_megakernel, dim3(grid), dim3(NWAVES * 64), args, LDS_BYTES, stream);
    if (e != hipSuccess) fprintf(stderr, "cooperative launch failed: %s (grid %d)\n", hipGetErrorString(e), grid);
}
```

```cpp
#include <hip/hip_runtime.h>
#include <hip/hip_cooperative_groups.h>
#include <cstdio>
#include <cstdint>
namespace cg = cooperative_groups;
namespace pg8 {
#define PG8_LAS __attribute__((address_space(3)))
typedef unsigned short bf16_t;
typedef short bf16x8 __attribute__((ext_vector_type(8)));
typedef float f32x4 __attribute__((ext_vector_type(4)));
typedef unsigned u32x4 __attribute__((ext_vector_type(4)));
constexpr int BM = 256, BK = 64, HALF = 128, HTB = HALF * BK * 2  , STAGE_BYTES = 8 * HTB, NXCD = 8, WGM = 8;

__host__ __device__ __forceinline__ int lds_byte(int r, int c) { const int st = (r >> 4) * 2 + (c >> 5), rr = r & 15, cc = c & 31, ob = rr * 64 + cc * 2; return st * 1024 + (ob ^ (((ob >> 9) & 1) << 5)); }
__host__ __device__ __forceinline__ void stage_rc(int b, int& R, int& C) { const int st = b / 1024, sb = b % 1024, swz = sb ^ (((sb >> 9) & 1) << 5); R = (st >> 1) * 16 + swz / 64; C = (st & 1) * 32 + (swz % 64) / 2; }
__host__ __device__ __forceinline__ int perm32(int rho) { const int n = rho >> 4, i = rho & 15; return 8 * (i >> 2) + 4 * n + (i & 3); }

struct Unit { int pm, pn; };
struct Gemm { const bf16_t* A; const bf16_t* Bt; int M, N, K; };

struct StaticOrder {
    int nM, nN, nwg, G, c;
    __host__ __device__ void init(int M, int N, int G_, int c_) { nM = M / BM; nN = N / BM; nwg = nM * nN; G = G_; c = c_; }
    __host__ __device__ bool next(int i, Unit& u) const {
        const long L = (long)i * G + c; if (L >= nwg) return false;
        int wgid = (int)L; { const int q = nwg / NXCD, r = nwg % NXCD, xcd = wgid % NXCD, off = wgid / NXCD; wgid = (xcd < r ? xcd * (q + 1) : r * (q + 1) + (xcd - r) * q) + off; }
        const int nig = WGM * nN, gid = wgid / nig, fm = gid * WGM, gsz = (nM - fm) < WGM ? (nM - fm) : WGM;
        u.pm = fm + ((wgid % nig) % gsz); u.pn = (wgid % nig) / gsz; return true;
    }
    __device__ __forceinline__ void a_ready(const Unit&) const {}
    __device__ __forceinline__ void done(const Unit&) const {}
};


#define PG8_GAS __attribute__((address_space(1)))
typedef float f32x2 __attribute__((ext_vector_type(2)));
typedef __bf16 bf16x2_t __attribute__((ext_vector_type(2)));
__device__ __forceinline__ unsigned cvtpk(float lo, float hi) { f32x2 v = {lo, hi}; bf16x2_t b = __builtin_convertvector(v, bf16x2_t); return __builtin_bit_cast(unsigned, b); }
__device__ __forceinline__ float silu_mul(float g, float u) { return g * u * __builtin_amdgcn_rcpf(1.0f + __builtin_amdgcn_exp2f(-1.4426950408889634f * g)); }

struct EpiSwiglu {
    static constexpr bool PERM = true, AFTER_DRAIN = false, MIDK = false;
    bf16_t* O; int ldc;
    __device__ __forceinline__ void operator()(const f32x4 (&acc)[2][2][4][2], const Unit& u, int wr, int wc, int fr, int fq) const {
        const int row0 = u.pm * BM + wr * 64 + fr, col0 = u.pn * HALF + wc * 32 + 8 * fq;
#pragma unroll
        for (int ai = 0; ai < 2; ++ai)
#pragma unroll
            for (int m = 0; m < 4; ++m) {
                bf16_t* p = O + (size_t)(row0 + ai * HALF + m * 16) * ldc + col0;
                const f32x4 g0 = acc[ai][0][m][0], g1 = acc[ai][0][m][1], u0 = acc[ai][1][m][0], u1 = acc[ai][1][m][1];
                u32x4 w;
                w.x = cvtpk(silu_mul(g0[0], u0[0]), silu_mul(g0[1], u0[1])); w.y = cvtpk(silu_mul(g0[2], u0[2]), silu_mul(g0[3], u0[3]));
                w.z = cvtpk(silu_mul(g1[0], u1[0]), silu_mul(g1[1], u1[1])); w.w = cvtpk(silu_mul(g1[2], u1[2]), silu_mul(g1[3], u1[3]));
                *(PG8_GAS u32x4*)p = w;
            }
    }
};
struct EpiResid {
    static constexpr bool PERM = true, AFTER_DRAIN = false, MIDK = true;
    const float* xin; bf16_t* xs; const float* mod; const float* ssq; const float* gnext; bf16_t* xn; float* outf; float* xbuf; unsigned* cnt; PG8_LAS unsigned char* ldx; int step, midk;
    __device__ __forceinline__ void mid(f32x4 (&acc)[2][2][4][2], const Unit& u, int wr, int fr_in) const {
        int fr = fr_in; asm volatile("" : "+v"(fr));
#pragma unroll
        for (int ai = 0; ai < 2; ++ai)
#pragma unroll
            for (int m = 0; m < 4; ++m) {
                const float s = 1.0f / sqrtf(((const PG8_GAS float*)ssq)[u.pm * BM + ai * HALF + wr * 64 + m * 16 + fr] * (1.0f / 512.0f) + 1e-6f);
#pragma unroll
                for (int bj = 0; bj < 2; ++bj)
#pragma unroll
                    for (int n = 0; n < 2; ++n) acc[ai][bj][m][n] = acc[ai][bj][m][n] * s;
            }
    }
    __device__ __forceinline__ void operator()(f32x4 (&acc)[2][2][4][2], const Unit& u, int wr_in, int wc_in, int fr_in, int fq_in) const {
        int wr = wr_in, wc = wc_in, fr = fr_in, fq = fq_in; asm volatile("" : "+s"(wr), "+s"(wc), "+v"(fr), "+v"(fq));
        const int b = (u.pm * BM) >> 13;
        const float* gp = mod + b * 9216 + step * 3072 + 2048; const float coef = step == 1 ? 1.0f : 0.5f;
        const float* basef = step == 0 ? xin : (const float*)nullptr;
        const int col0 = u.pn * BM + wc * 32 + 8 * fq;
        PG8_LAS float* P = (PG8_LAS float*)ldx;
        PG8_LAS float* S = (PG8_LAS float*)(ldx + 4096);
        PG8_LAS unsigned* flag = (PG8_LAS unsigned*)(ldx + 5120);
        {
            f32x4 gv[2][2];
#pragma unroll
            for (int bj = 0; bj < 2; ++bj)
#pragma unroll
                for (int n = 0; n < 2; ++n) gv[bj][n] = (*(const PG8_GAS f32x4*)(gp + col0 + bj * HALF + 4 * n) + 1.0f) * coef;
#pragma unroll
            for (int ai = 0; ai < 2; ++ai)
#pragma unroll
                for (int m = 0; m < 4; ++m) {
                    const int rt = ai * HALF + wr * 64 + m * 16 + fr;
                    const size_t off = (size_t)(u.pm * BM + rt) * 1024 + col0;
                    float ss = 0.f;
#pragma unroll
                    for (int bj = 0; bj < 2; ++bj) {
                        f32x4 b0, b1;
                        if (basef) { b0 = *(const PG8_GAS f32x4*)(basef + off + bj * HALF); b1 = *(const PG8_GAS f32x4*)(basef + off + bj * HALF + 4); }
                        else { const u32x4 w = *(const PG8_GAS u32x4*)(xs + off + bj * HALF);
                            b0 = (f32x4){__uint_as_float(w.x << 16), __uint_as_float(w.x & 0xffff0000u), __uint_as_float(w.y << 16), __uint_as_float(w.y & 0xffff0000u)};
                            b1 = (f32x4){__uint_as_float(w.z << 16), __uint_as_float(w.z & 0xffff0000u), __uint_as_float(w.w << 16), __uint_as_float(w.w & 0xffff0000u)}; }
                        const f32x4 o0 = b0 + gv[bj][0] * acc[ai][bj][m][0], o1 = b1 + gv[bj][1] * acc[ai][bj][m][1];
                        acc[ai][bj][m][0] = o0; acc[ai][bj][m][1] = o1;
                        ss += ((o0[0] * o0[0] + o0[1] * o0[1]) + (o0[2] * o0[2] + o0[3] * o0[3])) + ((o1[0] * o1[0] + o1[1] * o1[1]) + (o1[2] * o1[2] + o1[3] * o1[3]));
                    }
                    ss += __shfl_xor(ss, 16); ss += __shfl_xor(ss, 32);
                    if (fq == 0) P[rt * 4 + wc] = ss;
                }
        }
        asm volatile("s_waitcnt lgkmcnt(0)" ::: "memory"); __builtin_amdgcn_s_barrier(); asm volatile("" ::: "memory");
        const int wid = wr * 4 + wc, lane = fq * 16 + fr;
        if (wid < 4) {
            const int row = wid * 64 + lane;
            const f32x4 pv = *(const PG8_LAS f32x4*)(P + row * 4);
            __hip_atomic_store((PG8_GAS float*)xbuf + ((size_t)(u.pm * BM + row) * 4 + u.pn), (pv[0] + pv[1]) + (pv[2] + pv[3]), __ATOMIC_RELAXED, __HIP_MEMORY_SCOPE_AGENT);
            asm volatile("s_waitcnt vmcnt(0)" ::: "memory");
            if (lane == 0) (void)__hip_atomic_fetch_add((PG8_GAS unsigned*)cnt + u.pm, 1u, __ATOMIC_RELAXED, __HIP_MEMORY_SCOPE_AGENT);
        }
        if (step < 2) {
#pragma unroll
            for (int ai = 0; ai < 2; ++ai)
#pragma unroll
                for (int m = 0; m < 4; ++m) {
                    const size_t off = (size_t)(u.pm * BM + ai * HALF + wr * 64 + m * 16 + fr) * 1024 + col0;
#pragma unroll
                    for (int bj = 0; bj < 2; ++bj) { const f32x4 o0 = acc[ai][bj][m][0], o1 = acc[ai][bj][m][1];
                        u32x4 w; w.x = cvtpk(o0[0], o0[1]); w.y = cvtpk(o0[2], o0[3]); w.z = cvtpk(o1[0], o1[1]); w.w = cvtpk(o1[2], o1[3]);
                        *(PG8_GAS u32x4*)(xs + off + bj * HALF) = w; }
                }
        }
        if (wid == 0) {
            unsigned spins = 0;
            while ((unsigned)__builtin_amdgcn_readfirstlane((int)__hip_atomic_load((PG8_GAS unsigned*)cnt + u.pm, __ATOMIC_RELAXED, __HIP_MEMORY_SCOPE_AGENT)) < 16u) {
                __builtin_amdgcn_s_sleep(2); if (++spins > (1u << 18)) break; }
            __builtin_amdgcn_fence(__ATOMIC_ACQUIRE, "agent");
            if (lane == 0) flag[0] = 1u;
        }
        asm volatile("s_waitcnt lgkmcnt(0)" ::: "memory"); __builtin_amdgcn_s_barrier(); asm volatile("" ::: "memory");
        if (wid < 4) {
            const int row = wid * 64 + lane;
            const PG8_GAS float* sl = (const PG8_GAS float*)xbuf + (size_t)(u.pm * BM + row) * 4;
            const float t0 = __hip_atomic_load(sl, __ATOMIC_RELAXED, __HIP_MEMORY_SCOPE_AGENT), t1 = __hip_atomic_load(sl + 1, __ATOMIC_RELAXED, __HIP_MEMORY_SCOPE_AGENT),
                        t2 = __hip_atomic_load(sl + 2, __ATOMIC_RELAXED, __HIP_MEMORY_SCOPE_AGENT), t3 = __hip_atomic_load(sl + 3, __ATOMIC_RELAXED, __HIP_MEMORY_SCOPE_AGENT);
            S[row] = 1.0f / sqrtf(((t0 + t1) + (t2 + t3)) * (1.0f / 1024.0f) + 1e-6f);
        }
        asm volatile("s_waitcnt lgkmcnt(0)" ::: "memory"); __builtin_amdgcn_s_barrier(); asm volatile("" ::: "memory");
        if (step < 2) {
            const float* mb = mod + b * 9216 + (step + 1) * 3072;
#pragma unroll
            for (int bj = 0; bj < 2; ++bj) {
                const int c = col0 + bj * HALF;
                const f32x4 g0 = *(const PG8_GAS f32x4*)(gnext + c) * (*(const PG8_GAS f32x4*)(mb + 1024 + c) + 1.0f), g1 = *(const PG8_GAS f32x4*)(gnext + c + 4) * (*(const PG8_GAS f32x4*)(mb + 1024 + c + 4) + 1.0f);
                const f32x4 h0 = *(const PG8_GAS f32x4*)(mb + c), h1 = *(const PG8_GAS f32x4*)(mb + c + 4);
#pragma unroll
                for (int ai = 0; ai < 2; ++ai)
#pragma unroll
                    for (int m = 0; m < 4; ++m) {
                        const int rt = ai * HALF + wr * 64 + m * 16 + fr; const float rs = S[rt];
                        const f32x4 y0 = acc[ai][bj][m][0] * rs * g0 + h0, y1 = acc[ai][bj][m][1] * rs * g1 + h1;
                        u32x4 w; w.x = cvtpk(y0[0], y0[1]); w.y = cvtpk(y0[2], y0[3]); w.z = cvtpk(y1[0], y1[1]); w.w = cvtpk(y1[2], y1[3]);
                        *(PG8_GAS u32x4*)(xn + (size_t)(u.pm * BM + rt) * 1024 + c) = w;
                    }
            }
        } else {
#pragma unroll
            for (int bj = 0; bj < 2; ++bj) {
                const int c = col0 + bj * HALF;
                const f32x4 g0 = *(const PG8_GAS f32x4*)(gnext + c), g1 = *(const PG8_GAS f32x4*)(gnext + c + 4);
#pragma unroll
                for (int ai = 0; ai < 2; ++ai)
#pragma unroll
                    for (int m = 0; m < 4; ++m) {
                        const int rt = ai * HALF + wr * 64 + m * 16 + fr; const float rs = S[rt];
                        PG8_GAS f32x4* op = (PG8_GAS f32x4*)(outf + (size_t)(u.pm * BM + rt) * 1024 + c);
                        op[0] = acc[ai][bj][m][0] * rs * g0; op[1] = acc[ai][bj][m][1] * rs * g1;
                    }
            }
        }
        asm volatile("s_waitcnt lgkmcnt(0)" ::: "memory"); __builtin_amdgcn_s_barrier(); asm volatile("" ::: "memory");
    }
};
struct EpiProj {
    static constexpr bool PERM = true, AFTER_DRAIN = false, MIDK = false;
    bf16_t* O; const float* gq; const float* gk;
    __device__ __forceinline__ void operator()(const f32x4 (&acc)[2][2][4][2], const Unit& u, int wr, int wc, int fr, int fq) const {
        const int row0 = u.pm * BM + wr * 64 + fr, colh = u.pn * BM + wc * 64 + 8 * fq;
        if (u.pn < 4) {
            const float* g = (u.pn < 2) ? gq : gk; const float sc = (u.pn < 2) ? 0.125f * 1.4426950408889634f : 1.0f;
            f32x4 gv[2][2];
#pragma unroll
            for (int bj = 0; bj < 2; ++bj)
#pragma unroll
                for (int n = 0; n < 2; ++n) gv[bj][n] = *(const PG8_GAS f32x4*)(g + 32 * bj + 8 * fq + 4 * n) * sc;
#pragma unroll
            for (int ai = 0; ai < 2; ++ai)
#pragma unroll
                for (int m = 0; m < 4; ++m) {
                    float ss = 0.f;
#pragma unroll
                    for (int bj = 0; bj < 2; ++bj)
#pragma unroll
                        for (int n = 0; n < 2; ++n) { const f32x4 x = acc[ai][bj][m][n]; ss += (x[0] * x[0] + x[1] * x[1]) + (x[2] * x[2] + x[3] * x[3]); }
                    ss += __shfl_xor(ss, 16); ss += __shfl_xor(ss, 32);
                    const float rstd = 1.0f / sqrtf(ss * (1.0f / 64.0f) + 1e-6f);
                    bf16_t* p = O + (size_t)(row0 + ai * HALF + m * 16) * 3072 + colh;
#pragma unroll
                    for (int bj = 0; bj < 2; ++bj) {
                        const f32x4 v0 = acc[ai][bj][m][0] * rstd * gv[bj][0], v1 = acc[ai][bj][m][1] * rstd * gv[bj][1];
                        u32x4 w; w.x = cvtpk(v0[0], v0[1]); w.y = cvtpk(v0[2], v0[3]); w.z = cvtpk(v1[0], v1[1]); w.w = cvtpk(v1[2], v1[3]);
                        *(PG8_GAS u32x4*)(p + 32 * bj) = w;
                    }
                }
        } else {
#pragma unroll
            for (int ai = 0; ai < 2; ++ai)
#pragma unroll
                for (int m = 0; m < 4; ++m) {
                    bf16_t* p = O + (size_t)(row0 + ai * HALF + m * 16) * 3072 + colh;
#pragma unroll
                    for (int bj = 0; bj < 2; ++bj) {
                        const f32x4 v0 = acc[ai][bj][m][0], v1 = acc[ai][bj][m][1];
                        u32x4 w; w.x = cvtpk(v0[0], v0[1]); w.y = cvtpk(v0[2], v0[3]); w.z = cvtpk(v1[0], v1[1]); w.w = cvtpk(v1[2], v1[3]);
                        *(PG8_GAS u32x4*)(p + 32 * bj) = w;
                    }
                }
        }
    }
};

template <class Epi, class Sched, bool ALIGN_EPI = false, bool SP2 = false>
__device__ __forceinline__ void gemm_phase(PG8_LAS unsigned char* lds, const Gemm g, const Sched& S, const Epi& E, const int tid) {
    const int  wid = __builtin_amdgcn_readfirstlane(tid >> 6), lane = tid & 63, wr = wid >> 2, wc = wid & 3, fr = lane & 15, fq = lane >> 4;
    const int K = g.K, nt = K / BK;
    unsigned voffA[2], voffB[2];
#pragma unroll
    for (int i = 0; i < 2; ++i) { int R, C; stage_rc(tid * 16 + i * 8192, R, C); const int Rb = Epi::PERM ? ((R & ~31) + perm32(R & 31)) : R;
        voffA[i] = (unsigned)(R * K + C) * 2u; voffB[i] = (unsigned)(Rb * K + C) * 2u; }
    const size_t kstep = (size_t)(BK * 2);
    const size_t hstep = (size_t)HALF * K * 2;
    const size_t tstep = 2 * hstep;
    const unsigned ldsw = (unsigned)wid * 1024u;
    const int aoff = lds_byte(wr * 64 + fr, fq * 8), boff = lds_byte(wc * 32 + fr, fq * 8);
#define PG8_SA(b, h) (((b) * 2 + (h)) * HTB)
#define PG8_SB(b, h) ((4 + (b) * 2 + (h)) * HTB)
#define PG8_STAGE(bufoff, gbase, voff) do { _Pragma("unroll") for (int _i = 0; _i < 2; ++_i) \
        __builtin_amdgcn_global_load_lds((const unsigned*)((const char*)(gbase) + (voff)[_i]), (PG8_LAS unsigned*)(lds + (bufoff) + ldsw + _i * 8192), 16, 0, 0); } while (0)
#define PG8_LDA(dst, b, h) do { _Pragma("unroll") for (int m = 0; m < 4; ++m) _Pragma("unroll") for (int k = 0; k < 2; ++k) dst[m][k] = *(const PG8_LAS bf16x8*)(lds + PG8_SA(b, h) + aoff + m * 2048 + k * 1024); } while (0)
#define PG8_LDB(dst, b, h) do { _Pragma("unroll") for (int n = 0; n < 2; ++n) _Pragma("unroll") for (int k = 0; k < 2; ++k) dst[n][k] = *(const PG8_LAS bf16x8*)(lds + PG8_SB(b, h) + boff + n * 2048 + k * 1024); } while (0)
#define PG8_MMA(ai, bj, At, Bt) do { __builtin_amdgcn_s_setprio(1); _Pragma("unroll") for (int m = 0; m < 4; ++m) _Pragma("unroll") for (int n = 0; n < 2; ++n) _Pragma("unroll") for (int k = 0; k < 2; ++k) \
        acc[ai][bj][m][n] = __builtin_amdgcn_mfma_f32_16x16x32_bf16(Bt[n][k], At[m][k], acc[ai][bj][m][n], 0, 0, 0); __builtin_amdgcn_s_setprio(0); } while (0)
#define PG8_WAIT_V(n) asm volatile("s_waitcnt vmcnt(" #n ")" ::: "memory")
#define PG8_WAIT_L(n) asm volatile("s_waitcnt lgkmcnt(" #n ")" ::: "memory")
#define PG8_BAR __builtin_amdgcn_s_barrier()
#define PG8_SCHED __builtin_amdgcn_sched_barrier(0)
    Unit cur, nxt; int ui = 0;
    if (!S.next(0, cur)) return;
    f32x4 acc[2][2][4][2];
#pragma unroll
    for (int a = 0; a < 2; ++a)
#pragma unroll
        for (int b = 0; b < 2; ++b)
#pragma unroll
            for (int m = 0; m < 4; ++m)
#pragma unroll
                for (int n = 0; n < 2; ++n) acc[a][b][m][n] = (f32x4){0.f, 0.f, 0.f, 0.f};
    bf16x8 At[4][2], B0[2][2], B1[2][2];
    const char* cA = (const char*)g.A + (size_t)cur.pm * tstep; const char* cB = (const char*)g.Bt + (size_t)cur.pn * tstep;
    S.a_ready(cur);
    if constexpr (SP2) {
        PG8_STAGE(PG8_SB(0, 0), cB, voffB); PG8_STAGE(PG8_SB(0, 1), cB + hstep, voffB); PG8_STAGE(PG8_SA(0, 0), cA, voffA); PG8_STAGE(PG8_SA(0, 1), cA + hstep, voffA);
        if (wr == 1) PG8_BAR;
        PG8_WAIT_V(2); PG8_BAR;
        PG8_STAGE(PG8_SB(1, 0), cB + kstep, voffB); PG8_STAGE(PG8_SA(1, 0), cA + kstep, voffA); PG8_STAGE(PG8_SB(1, 1), cB + hstep + kstep, voffB);
        PG8_WAIT_V(6); PG8_BAR;
    } else {
        PG8_STAGE(PG8_SB(0, 0), cB, voffB); PG8_STAGE(PG8_SA(0, 0), cA, voffA); PG8_STAGE(PG8_SB(0, 1), cB + hstep, voffB); PG8_STAGE(PG8_SA(0, 1), cA + hstep, voffA);
        if (wr == 1) PG8_BAR;
        PG8_WAIT_V(4); PG8_BAR;
        PG8_STAGE(PG8_SB(1, 0), cB + kstep, voffB); PG8_STAGE(PG8_SA(1, 0), cA + kstep, voffA); PG8_STAGE(PG8_SB(1, 1), cB + hstep + kstep, voffB);
        PG8_WAIT_V(6); PG8_BAR;
    }
    for (;;) {
        const bool has_next = S.next(ui + 1, nxt);
        const char* nA = has_next ? (const char*)g.A + (size_t)nxt.pm * tstep : cA; const char* nB = has_next ? (const char*)g.Bt + (size_t)nxt.pn * tstep : cB;
        for (int t = 0; t < nt; t += 2) {
            if constexpr (Epi::MIDK) { if (t == E.midk) E.mid(acc, cur, wr, fr); }
            const bool last = (t == nt - 2);
            const char* a1 = cA + (size_t)(t + 1) * kstep;
            const char* a2 = last ? nA : cA + (size_t)(t + 2) * kstep; const char* b2 = last ? nB : cB + (size_t)(t + 2) * kstep;
            const char* a3 = a2 + kstep; const char* b3 = b2 + kstep;
            if (last && has_next) S.a_ready(nxt);
            if constexpr (SP2) {
            PG8_LDB(B0, 0, 0); PG8_LDB(B1, 0, 1); PG8_SCHED; PG8_LDA(At, 0, 0); PG8_STAGE(PG8_SA(1, 1), a1 + hstep, voffA);
            PG8_WAIT_V(8); PG8_WAIT_L(0); PG8_BAR; PG8_MMA(0, 0, At, B0); PG8_MMA(0, 1, At, B1); PG8_BAR; PG8_SCHED;
            PG8_LDA(At, 0, 1); PG8_STAGE(PG8_SB(0, 0), b2, voffB); PG8_STAGE(PG8_SB(0, 1), b2 + hstep, voffB); PG8_STAGE(PG8_SA(0, 0), a2, voffA);
            PG8_WAIT_V(8); PG8_WAIT_L(0); PG8_BAR; PG8_MMA(1, 0, At, B0); PG8_MMA(1, 1, At, B1); PG8_BAR; PG8_SCHED;
            PG8_LDB(B0, 1, 0); PG8_LDB(B1, 1, 1); PG8_SCHED; PG8_LDA(At, 1, 0); PG8_STAGE(PG8_SA(0, 1), a2 + hstep, voffA);
            PG8_WAIT_V(8); PG8_WAIT_L(0); PG8_BAR; PG8_MMA(0, 0, At, B0); PG8_MMA(0, 1, At, B1); PG8_BAR; PG8_SCHED;
            PG8_LDA(At, 1, 1); PG8_STAGE(PG8_SB(1, 0), b3, voffB); PG8_STAGE(PG8_SB(1, 1), b3 + hstep, voffB); PG8_STAGE(PG8_SA(1, 0), a3, voffA);
            PG8_WAIT_V(8); PG8_WAIT_L(0); PG8_BAR; PG8_MMA(1, 0, At, B0); PG8_MMA(1, 1, At, B1); PG8_BAR; PG8_SCHED;
            } else {
            PG8_LDB(B0, 0, 0); PG8_SCHED; PG8_LDA(At, 0, 0); PG8_STAGE(PG8_SA(1, 1), a1 + hstep, voffA);
            PG8_WAIT_L(8); PG8_BAR; PG8_WAIT_L(0); PG8_MMA(0, 0, At, B0); PG8_BAR; PG8_SCHED;
            PG8_LDB(B1, 0, 1); PG8_STAGE(PG8_SB(0, 0), b2, voffB);
            PG8_BAR; PG8_WAIT_L(0); PG8_MMA(0, 1, At, B1); PG8_BAR;
            PG8_LDA(At, 0, 1); PG8_STAGE(PG8_SA(0, 0), a2, voffA);
            PG8_BAR; PG8_WAIT_L(0); PG8_MMA(1, 0, At, B0); PG8_BAR; PG8_SCHED;
            PG8_STAGE(PG8_SB(0, 1), b2 + hstep, voffB);
            PG8_WAIT_V(6); PG8_BAR; PG8_MMA(1, 1, At, B1); PG8_BAR;
            PG8_LDB(B0, 1, 0); PG8_SCHED; PG8_LDA(At, 1, 0); PG8_STAGE(PG8_SA(0, 1), a2 + hstep, voffA);
            PG8_WAIT_L(8); PG8_BAR; PG8_WAIT_L(0); PG8_MMA(0, 0, At, B0); PG8_BAR; PG8_SCHED;
            PG8_LDB(B1, 1, 1); PG8_STAGE(PG8_SB(1, 0), b3, voffB);
            PG8_BAR; PG8_WAIT_L(0); PG8_MMA(0, 1, At, B1); PG8_BAR;
            PG8_LDA(At, 1, 1); PG8_STAGE(PG8_SA(1, 0), a3, voffA);
            PG8_BAR; PG8_WAIT_L(0); PG8_MMA(1, 0, At, B0); PG8_BAR; PG8_SCHED;
            PG8_STAGE(PG8_SB(1, 1), b3 + hstep, voffB);
            PG8_WAIT_V(6); PG8_BAR; PG8_MMA(1, 1, At, B1); PG8_BAR;
            }
        }
        if constexpr (ALIGN_EPI) { if (wr == 0) PG8_BAR; }
        if constexpr (!Epi::AFTER_DRAIN) { E(acc, cur, wr, wc, fr, fq); S.done(cur); }
        if (!has_next) break;
#pragma unroll
        for (int a = 0; a < 2; ++a)
#pragma unroll
            for (int b = 0; b < 2; ++b)
#pragma unroll
                for (int m = 0; m < 4; ++m)
#pragma unroll
                    for (int n = 0; n < 2; ++n) acc[a][b][m][n] = (f32x4){0.f, 0.f, 0.f, 0.f};
        cur = nxt; cA = nA; cB = nB; ++ui;
        if constexpr (ALIGN_EPI) { if (wr == 1) PG8_BAR; }
    }
    PG8_WAIT_V(0);
    if constexpr (!ALIGN_EPI) { if (wr == 0) PG8_BAR; }
    PG8_BAR;
    if constexpr (Epi::AFTER_DRAIN) { E.fused(acc, cur, wr, wc, fr, fq, lds, wid, lane); S.done(cur); }
#undef PG8_SA
#undef PG8_SB
#undef PG8_STAGE
#undef PG8_LDA
#undef PG8_LDB
#undef PG8_MMA
#undef PG8_WAIT_V
#undef PG8_WAIT_L
#undef PG8_BAR
#undef PG8_SCHED
}
}

#define LAS __attribute__((address_space(3)))
typedef unsigned short bf16;
typedef float f32x4 __attribute__((ext_vector_type(4)));
typedef short bf16x8 __attribute__((ext_vector_type(8)));
typedef unsigned u32x4 __attribute__((ext_vector_type(4)));
typedef unsigned u32x2 __attribute__((ext_vector_type(2)));
using pg8::cvtpk;

#ifndef KN_NORM
#define KN_NORM 1
#endif
#ifndef KN_UP
#define KN_UP 1
#endif
#ifndef KN_PROJ
#define KN_PROJ 1
#endif
#ifndef KN_ATT
#define KN_ATT 1
#endif
#ifndef KN_CONV
#define KN_CONV 1
#endif
#ifndef KN_RES0
#define KN_RES0 1
#endif
#ifndef KN_SYNC
#define KN_SYNC 0
#endif
constexpr int NWAVES = 8;
constexpr int BATCH = 8, SEQ = 8192, D = 1024, DFF = 2816, NPROJ = 3072, M = BATCH * SEQ;
constexpr int NMOD = 9216;
constexpr float EPS = 1e-6f;
constexpr float L2E = 1.4426950408889634f;
constexpr int LDS_BYTES = 147456;

constexpr size_t MiB = 1u << 20;
constexpr size_t WS_MOD = 0;
constexpr size_t MOD_BYTES = (size_t)BATCH * NMOD * 4;
constexpr size_t WS_BAR = 512 * 1024;
constexpr size_t WS_SSQ = 576 * 1024;
constexpr size_t WS_CNT = 960 * 1024;
constexpr size_t CTL_ZERO_BYTES = 1 * MiB;
constexpr size_t WS_W1IN = 2 * MiB, WS_W1OUT = 13 * MiB, WS_WIN = 19 * MiB, WS_WOUT = 25 * MiB, WS_W2IN = 27 * MiB, WS_W2OUT = 38 * MiB;
constexpr size_t WS_XN = 64 * MiB;
constexpr size_t WS_ACT = 192 * MiB;
constexpr size_t WS_XS = 576 * MiB;
constexpr size_t WS_XN2 = 704 * MiB;
constexpr size_t WS_XBUF = 832 * MiB;
constexpr size_t WS_END = 835 * MiB;

__device__ __forceinline__ int fresh_lane() { int z = 0; asm volatile("" : "+v"(z)); return (int)__builtin_amdgcn_mbcnt_hi(~0u, __builtin_amdgcn_mbcnt_lo(~0u, (unsigned)z)); }
__device__ __forceinline__ int launder_s(int v) { asm volatile("" : "+s"(v)); return v; }
__device__ __forceinline__ int launder_v(int v) { asm volatile("" : "+v"(v)); return v; }
__device__ __forceinline__ int opaque_zero() { int z = 0; asm volatile("" : "+s"(z)); return z; }
template <class T> __device__ __forceinline__ T* launder(T* p) { asm volatile("" : "+s"(p)); return p; }
#define GAS __attribute__((address_space(1)))
template <class T> __device__ __forceinline__ GAS T* gp(T* p) { return (GAS T*)p; }
__device__ __forceinline__ float wave_sum(float v) {
#pragma unroll
    for (int o = 1; o < 64; o <<= 1) v += __shfl_xor(v, o);
    return v;
}
__device__ __forceinline__ float wave_max(float v) {
#pragma unroll
    for (int o = 1; o < 64; o <<= 1) v = fmaxf(v, __shfl_xor(v, o));
    return v;
}
__device__ __forceinline__ float bf_lo(unsigned w) { return __uint_as_float(w << 16); }
__device__ __forceinline__ float bf_hi(unsigned w) { return __uint_as_float(w & 0xffff0000u); }

__device__ __forceinline__ void transpose_item(const float* W, int K, int N, bf16* WT, int k0, int n0, int drow0, LAS float* scr, int lane, const float* kscale = nullptr) {
    {
        f32x4 w[8]; const int c4 = lane & 7, r8 = lane >> 3;
#pragma unroll
        for (int i = 0; i < 8; ++i) w[i] = *(const GAS f32x4*)(W + (size_t)(k0 + 8 * i + r8) * N + n0 + 4 * c4);
#pragma unroll
        for (int i = 0; i < 8; ++i) { const int kk = 8 * i + r8; f32x4 v = w[i]; if (kscale) v = v * ((const GAS float*)kscale)[k0 + kk];
            LAS float* d = scr + kk * 33 + 4 * c4; d[0] = v[0]; d[1] = v[1]; d[2] = v[2]; d[3] = v[3]; }
    }
    asm volatile("s_waitcnt lgkmcnt(0)" ::: "memory");
    const int c = lane & 7;
#pragma unroll
    for (int j = 0; j < 4; ++j) { const int n = (lane >> 3) + 8 * j; const LAS float* s = scr + (8 * c) * 33 + n;
        u32x4 o; o.x = cvtpk(s[0 * 33], s[1 * 33]); o.y = cvtpk(s[2 * 33], s[3 * 33]); o.z = cvtpk(s[4 * 33], s[5 * 33]); o.w = cvtpk(s[6 * 33], s[7 * 33]);
        *(GAS u32x4*)(WT + (size_t)(drow0 + n) * K + k0 + 8 * c) = o; }
    asm volatile("s_waitcnt lgkmcnt(0)" ::: "memory");
}
__device__ __forceinline__ int drow_plain(int n0) { return n0; }
__device__ __forceinline__ int drow_swiglu(int n0) { return n0 < DFF ? (n0 >> 7) * 256 + (n0 & 127) : ((n0 - DFF) >> 7) * 256 + 128 + ((n0 - DFF) & 127); }
__device__ __forceinline__ int drow_proj(int n0) { const int L = n0 & 255; return (n0 & ~255) + 128 * ((L >> 5) & 1) + 32 * (L >> 6); }

template <int R> __device__ __forceinline__ void norm_rows_bf16(const float* x, bf16* o, int m0, int rstride, const float* g, const float* shift, const float* scale, int lane) {
    f32x4 v[R][4]; float s[R];
#pragma unroll
    for (int r = 0; r < R; ++r) { const GAS f32x4* xr = (const GAS f32x4*)(x + (size_t)(m0 + r * rstride) * D) + lane;
#pragma unroll
        for (int j = 0; j < 4; ++j) v[r][j] = xr[64 * j]; }
#pragma unroll
    for (int r = 0; r < R; ++r) { s[r] = 0.f;
#pragma unroll
        for (int j = 0; j < 4; ++j) s[r] += (v[r][j].x * v[r][j].x + v[r][j].y * v[r][j].y) + (v[r][j].z * v[r][j].z + v[r][j].w * v[r][j].w); }
#pragma unroll
    for (int of = 1; of < 64; of <<= 1) {
#pragma unroll
        for (int r = 0; r < R; ++r) s[r] += __shfl_xor(s[r], of); }
#pragma unroll
    for (int j = 0; j < 4; ++j) {
        const f32x4 gg = ((const GAS f32x4*)g)[lane + 64 * j], sh = ((const GAS f32x4*)shift)[lane + 64 * j], sc = ((const GAS f32x4*)scale)[lane + 64 * j];
        const f32x4 gs = gg * (sc + 1.0f);
#pragma unroll
        for (int r = 0; r < R; ++r) {
            const float rstd = 1.0f / sqrtf(s[r] * (1.0f / D) + EPS);
            const f32x4 y = v[r][j] * rstd * gs + sh;
            u32x2 w; w.x = cvtpk(y.x, y.y); w.y = cvtpk(y.z, y.w); ((GAS u32x2*)(o + (size_t)(m0 + r * rstride) * D) + lane)[64 * j] = w;
        }
    }
}
template <int R> __device__ __forceinline__ void final_norm_rows(float* x, int m0, int rstride, const float* g, int lane) {
    f32x4 v[R][4]; float s[R];
#pragma unroll
    for (int r = 0; r < R; ++r) { const GAS f32x4* xr = (const GAS f32x4*)(x + (size_t)(m0 + r * rstride) * D) + lane;
#pragma unroll
        for (int j = 0; j < 4; ++j) v[r][j] = xr[64 * j]; }
#pragma unroll
    for (int r = 0; r < R; ++r) { s[r] = 0.f;
#pragma unroll
        for (int j = 0; j < 4; ++j) s[r] += (v[r][j].x * v[r][j].x + v[r][j].y * v[r][j].y) + (v[r][j].z * v[r][j].z + v[r][j].w * v[r][j].w); }
#pragma unroll
    for (int of = 1; of < 64; of <<= 1) {
#pragma unroll
        for (int r = 0; r < R; ++r) s[r] += __shfl_xor(s[r], of); }
#pragma unroll
    for (int j = 0; j < 4; ++j) {
        const f32x4 gg = ((const GAS f32x4*)g)[lane + 64 * j];
#pragma unroll
        for (int r = 0; r < R; ++r) {
            const float rstd = 1.0f / sqrtf(s[r] * (1.0f / D) + EPS);
            ((GAS f32x4*)(x + (size_t)(m0 + r * rstride) * D) + lane)[64 * j] = v[r][j] * rstd * gg;
        }
    }
}

__device__ __forceinline__ f32x4 unpack_lo4(const u32x4 w) { return (f32x4){bf_lo(w.x), bf_hi(w.x), bf_lo(w.y), bf_hi(w.y)}; }
__device__ __forceinline__ f32x4 unpack_hi4(const u32x4 w) { return (f32x4){bf_lo(w.z), bf_hi(w.z), bf_lo(w.w), bf_hi(w.w)}; }
__device__ __forceinline__ float sumsq8(const u32x4 w) { const f32x4 a = unpack_lo4(w), b = unpack_hi4(w); return ((a.x * a.x + a.y * a.y) + (a.z * a.z + a.w * a.w)) + ((b.x * b.x + b.y * b.y) + (b.z * b.z + b.w * b.w)); }
template <int R> __device__ __forceinline__ void norm_rows_bf16in(const bf16* x, bf16* o, int m0, int rstride, const float* g, const float* shift, const float* scale, int lane) {
    u32x4 v[R][2]; float s[R];
#pragma unroll
    for (int r = 0; r < R; ++r) { const GAS u32x4* xr = (const GAS u32x4*)(x + (size_t)(m0 + r * rstride) * D) + lane; v[r][0] = xr[0]; v[r][1] = xr[64]; }
#pragma unroll
    for (int r = 0; r < R; ++r) { s[r] = 0.f;
#pragma unroll
        for (int j = 0; j < 2; ++j) s[r] += sumsq8(v[r][j]); }
#pragma unroll
    for (int of = 1; of < 64; of <<= 1) {
#pragma unroll
        for (int r = 0; r < R; ++r) s[r] += __shfl_xor(s[r], of); }
#pragma unroll
    for (int j = 0; j < 2; ++j) {
        const int i4 = 2 * (lane + 64 * j);
        const f32x4 g0 = ((const GAS f32x4*)g)[i4], g1 = ((const GAS f32x4*)g)[i4 + 1], h0 = ((const GAS f32x4*)shift)[i4], h1 = ((const GAS f32x4*)shift)[i4 + 1], c0 = ((const GAS f32x4*)scale)[i4], c1 = ((const GAS f32x4*)scale)[i4 + 1];
        const f32x4 gs0 = g0 * (c0 + 1.0f), gs1 = g1 * (c1 + 1.0f);
#pragma unroll
        for (int r = 0; r < R; ++r) {
            const float rstd = 1.0f / sqrtf(s[r] * (1.0f / D) + EPS);
            const f32x4 y0 = unpack_lo4(v[r][j]) * rstd * gs0 + h0, y1 = unpack_hi4(v[r][j]) * rstd * gs1 + h1;
            u32x4 w; w.x = cvtpk(y0.x, y0.y); w.y = cvtpk(y0.z, y0.w); w.z = cvtpk(y1.x, y1.y); w.w = cvtpk(y1.z, y1.w);
            ((GAS u32x4*)(o + (size_t)(m0 + r * rstride) * D) + lane)[64 * j] = w;
        }
    }
}
template <int R> __device__ __forceinline__ void final_norm_rows_bf16in(const bf16* x, float* o, int m0, int rstride, const float* g, int lane) {
    u32x4 v[R][2]; float s[R];
#pragma unroll
    for (int r = 0; r < R; ++r) { const GAS u32x4* xr = (const GAS u32x4*)(x + (size_t)(m0 + r * rstride) * D) + lane; v[r][0] = xr[0]; v[r][1] = xr[64]; }
#pragma unroll
    for (int r = 0; r < R; ++r) { s[r] = 0.f;
#pragma unroll
        for (int j = 0; j < 2; ++j) s[r] += sumsq8(v[r][j]); }
#pragma unroll
    for (int of = 1; of < 64; of <<= 1) {
#pragma unroll
        for (int r = 0; r < R; ++r) s[r] += __shfl_xor(s[r], of); }
#pragma unroll
    for (int j = 0; j < 2; ++j) {
        const int i4 = 2 * (lane + 64 * j);
        const f32x4 g0 = ((const GAS f32x4*)g)[i4], g1 = ((const GAS f32x4*)g)[i4 + 1];
#pragma unroll
        for (int r = 0; r < R; ++r) {
            const float rstd = 1.0f / sqrtf(s[r] * (1.0f / D) + EPS);
            GAS f32x4* op = (GAS f32x4*)(o + (size_t)(m0 + r * rstride) * D) + i4;
            op[0] = unpack_lo4(v[r][j]) * rstd * g0; op[1] = unpack_hi4(v[r][j]) * rstd * g1;
        }
    }
}

__device__ __forceinline__ void mod_item(const float* c, const float* w_ada, const float* b_ada, float* mod, int item, int lane) {
    const int ks = item / 36, nb = item % 36, k0 = ks * 64, n0 = nb * 256 + 4 * lane;
    float sv[BATCH];
#pragma unroll
    for (int b = 0; b < BATCH; ++b) { const float x = c[b * D + k0 + lane]; sv[b] = x * __builtin_amdgcn_rcpf(1.0f + __builtin_amdgcn_exp2f(-L2E * x)); }
    f32x4 acc[BATCH];
#pragma unroll
    for (int b = 0; b < BATCH; ++b) acc[b] = (f32x4){0.f, 0.f, 0.f, 0.f};
    const float* wp = w_ada + (size_t)k0 * NMOD + n0;
#pragma unroll 8
    for (int kk = 0; kk < 64; ++kk) {
        const f32x4 w = *(const f32x4*)(wp + (size_t)kk * NMOD);
#pragma unroll
        for (int b = 0; b < BATCH; ++b) { const float s = __builtin_bit_cast(float, __builtin_amdgcn_readlane(__builtin_bit_cast(int, sv[b]), kk)); acc[b] += w * s; }
    }
    if (ks == 0) { const f32x4 bb = *(const f32x4*)(b_ada + n0);
#pragma unroll
        for (int b = 0; b < BATCH; ++b) acc[b] += bb; }
#pragma unroll
    for (int b = 0; b < BATCH; ++b) { float* mp = mod + b * NMOD + n0; atomicAdd(mp, acc[b].x); atomicAdd(mp + 1, acc[b].y); atomicAdd(mp + 2, acc[b].z); atomicAdd(mp + 3, acc[b].w); }
}

constexpr int KP = 144;
constexpr int AT_TILE = 64 * KP, AT_STAGE = 4 * AT_TILE;
constexpr int AT_TB = 2 * AT_STAGE;
static_assert(AT_TB + 257 * 4 <= 131072, "attention LDS map");

__device__ __forceinline__ void attn_bias_table(LAS unsigned char* lds, const float* relb, const float* gqn, const float* gkn, int h, int lane, int tid) {
    LAS float* tb = (LAS float*)(lds + AT_TB);
    {
        const float mq = wave_max(fabsf(gp(gqn)[lane])), mk = wave_max(fabsf(gp(gkn)[lane]));
        float bm = -3.0e38f;
#pragma unroll
        for (int j = 0; j < 5; ++j) { const int idx = lane + 64 * j; bm = fmaxf(bm, idx < 257 ? gp(relb)[h * 257 + idx] : -3.0e38f); }
        bm = wave_max(bm);
        const float B = L2E * (8.1f * mq * mk + bm);
        if (tid < 257) tb[tid] = L2E * gp(relb)[h * 257 + tid] - B;
    }
}
__device__ __forceinline__ void attn_unit(LAS unsigned char* lds, const bf16* PROJ, bf16* YMIX, float* ssq, const float* relb, const float* gqn, const float* gkn,
                                          int b, int h, int c0, int wave, int lane_in, int tid_in) {
    const int lane = launder_v(lane_in), tid = launder_v(tid_in); wave = launder_s(wave);
    const int fr = lane & 15, fq = lane >> 4;
    const LAS float* tb = (const LAS float*)(lds + AT_TB);
    const int r4 = wave & 3, par = wave >> 2;
    const size_t tok0 = (size_t)b * SEQ + (size_t)(c0 + par) * 64 + 16 * r4;
    bf16x8 qf[4][2];
#pragma unroll
    for (int nq = 0; nq < 4; ++nq)
#pragma unroll
        for (int kk = 0; kk < 2; ++kk) qf[nq][kk] = *(const GAS bf16x8*)(PROJ + (tok0 + 128 * nq + fr) * NPROJ + h * 64 + 32 * kk + 8 * fq);
    f32x4 O[4][4], L[4];
    const bf16x8 ones8 = {(short)0x3f80, (short)0x3f80, (short)0x3f80, (short)0x3f80, (short)0x3f80, (short)0x3f80, (short)0x3f80, (short)0x3f80};
#pragma unroll
    for (int md = 0; md < 4; ++md)
#pragma unroll
        for (int nq = 0; nq < 4; ++nq) O[md][nq] = (f32x4){0.f, 0.f, 0.f, 0.f};
#pragma unroll
    for (int nq = 0; nq < 4; ++nq) L[nq] = (f32x4){0.f, 0.f, 0.f, 0.f};
    const int j0 = (c0 == 0) ? 8 : 0;
    const int skey = tid >> 3, sd = (tid & 7) * 8;
    const bf16* Kg = PROJ + ((size_t)b * SEQ + (size_t)((c0 - 8 + j0) * 64 + skey)) * NPROJ + 512 + h * 64 + sd;
    const LAS unsigned char* const rd0 = lds;
    LAS unsigned char* const wr0 = lds + skey * KP + sd * 2;
    const bf16* Kg2 = Kg + (size_t)64 * NPROJ;
    u32x4 pa[4], pb[4];
#define AT_GLOAD(dst) do { asm volatile("global_load_dwordx4 %0, %1, off" : "=&v"(dst[0]) : "v"(Kg) : "memory"); asm volatile("global_load_dwordx4 %0, %1, off offset:1024" : "=&v"(dst[1]) : "v"(Kg) : "memory"); \
        asm volatile("global_load_dwordx4 %0, %1, off" : "=&v"(dst[2]) : "v"(Kg2) : "memory"); asm volatile("global_load_dwordx4 %0, %1, off offset:1024" : "=&v"(dst[3]) : "v"(Kg2) : "memory"); \
        Kg += (size_t)128 * NPROJ; Kg2 += (size_t)128 * NPROJ; } while (0)
#define AT_WAIT4(src) asm volatile("s_waitcnt vmcnt(4)" : "+v"(src[0]), "+v"(src[1]), "+v"(src[2]), "+v"(src[3]) :: "memory")
#define AT_WAIT0(src) asm volatile("s_waitcnt vmcnt(0)" : "+v"(src[0]), "+v"(src[1]), "+v"(src[2]), "+v"(src[3]) :: "memory")
#define AT_STORE(src, stage) do { _Pragma("unroll") for (int q_ = 0; q_ < 4; ++q_) *(LAS u32x4*)(wr0 + (stage) * AT_STAGE + q_ * AT_TILE) = src[q_]; } while (0)
    asm volatile("s_waitcnt vmcnt(0)" ::: "memory");
    AT_GLOAD(pa); AT_WAIT0(pa); AT_STORE(pa, 0);
    AT_GLOAD(pb);
    AT_GLOAD(pa);
#define AT_QK(S, nq) do { _Pragma("unroll") for (int mk = 0; mk < 2; ++mk) _Pragma("unroll") for (int kk = 0; kk < 2; ++kk) S[mk] = __builtin_amdgcn_mfma_f32_16x16x32_bf16(kf[mk][kk], qf[nq][kk], S[mk], 0, 0, 0); } while (0)
#define AT_EXP(S, pb, nq) do { float p[8]; _Pragma("unroll") for (int i = 0; i < 4; ++i) { p[i] = __builtin_amdgcn_exp2f(S[0][i]); p[4 + i] = __builtin_amdgcn_exp2f(S[1][i]); } \
        const u32x4 pk = {cvtpk(p[0], p[1]), cvtpk(p[2], p[3]), cvtpk(p[4], p[5]), cvtpk(p[6], p[7])}; pb = __builtin_bit_cast(bf16x8, pk); } while (0)
#define AT_PV(pb, nq) do { _Pragma("unroll") for (int md = 0; md < 4; ++md) O[md][nq] = __builtin_amdgcn_mfma_f32_16x16x32_bf16(vf[md], pb, O[md][nq], 0, 0, 0); \
        L[nq] = __builtin_amdgcn_mfma_f32_16x16x32_bf16(ones8, pb, L[nq], 0, 0, 0); } while (0)
#define AT_QK_C(S, nq) do { _Pragma("unroll") for (int mk = 0; mk < 2; ++mk) { S[mk] = __builtin_amdgcn_mfma_f32_16x16x32_bf16(kf[mk][0], qf[nq][0], c4v, 0, 0, 0); S[mk] = __builtin_amdgcn_mfma_f32_16x16x32_bf16(kf[mk][1], qf[nq][1], S[mk], 0, 0, 0); } } while (0)
#define AT_INIT_T(S, nq) do { _Pragma("unroll") for (int mk = 0; mk < 2; ++mk) { const int base = 64 * t + 32 * sub - 384 + 16 * mk + 4 * fq - 16 * r4 - fr; \
        _Pragma("unroll") for (int i = 0; i < 4; ++i) { const int idx = base + i; S[mk][i] = tb[idx > 0 ? idx : 0]; } } } while (0)
#define AT_STEP(j, soff) do { \
        const float c0v = tb[0]; const f32x4 c4v = {c0v, c0v, c0v, c0v}; \
        _Pragma("unroll") for (int sub = 0; sub < 2; ++sub) { \
            const LAS unsigned char* kb = rd0 + (soff) + sub * 32 * KP; const LAS unsigned char* vb = kb + AT_TILE; \
            bf16x8 kf[2][2], vf[4]; \
            _Pragma("unroll") for (int mk = 0; mk < 2; ++mk) _Pragma("unroll") for (int kk = 0; kk < 2; ++kk) kf[mk][kk] = *(const LAS bf16x8*)(kb + (16 * mk + fr) * KP + (32 * kk + 8 * fq) * 2); \
            _Pragma("unroll") for (int md = 0; md < 4; ++md) { \
                const v4i16_t lo = __builtin_amdgcn_ds_read_tr16_b64_v4i16((LAS v4i16_t*)(vb + (4 * fq + (fr >> 2)) * KP + (16 * md + 4 * (fr & 3)) * 2)); \
                const v4i16_t hi = __builtin_amdgcn_ds_read_tr16_b64_v4i16((LAS v4i16_t*)(vb + (16 + 4 * fq + (fr >> 2)) * KP + (16 * md + 4 * (fr & 3)) * 2)); \
                vf[md] = (bf16x8){lo[0], lo[1], lo[2], lo[3], hi[0], hi[1], hi[2], hi[3]}; } \
            _Pragma("unroll") for (int nq = 0; nq < 4; ++nq) { \
                const int t = (j) - 2 * nq - par; \
                if (t >= 0 && t <= 8) { f32x4 S[2]; bf16x8 pb; \
                    if (t < 6) { AT_QK_C(S, nq); } else { AT_INIT_T(S, nq); AT_QK(S, nq); } \
                    AT_EXP(S, pb, nq); AT_PV(pb, nq); } \
            } \
        } } while (0)
    typedef short v4i16_t __attribute__((ext_vector_type(4)));
    for (int jp = j0 >> 1; jp < 8; jp += 2) {
        __syncthreads();
        AT_STEP(2 * jp, 0);
        AT_STEP(2 * jp + 1, 2 * AT_TILE);
        if (jp + 2 < 8) AT_WAIT4(pb); else AT_WAIT0(pb);
        AT_STORE(pb, 1);
        if (jp + 3 < 8) AT_GLOAD(pb);
        __syncthreads();
        AT_STEP(2 * jp + 2, AT_STAGE);
        AT_STEP(2 * jp + 3, AT_STAGE + 2 * AT_TILE);
        if (jp + 2 < 8) {
            if (jp + 3 < 8) AT_WAIT4(pa); else AT_WAIT0(pa);
            AT_STORE(pa, 0);
            if (jp + 4 < 8) AT_GLOAD(pa);
        }
    }
#undef AT_GLOAD
#undef AT_WAIT4
#undef AT_WAIT0
#undef AT_LOAD
#undef AT_STORE
#undef AT_STEP
#undef AT_BODY
#undef AT_QK
#undef AT_EXP
#undef AT_PV
#undef AT_QK_C
#undef AT_INIT_T
    const int lane3 = launder_v(lane_in), fr3 = lane3 & 15, fq3 = lane3 >> 4;
#pragma unroll
    for (int nq = 0; nq < 4; ++nq) {
        const float inv = 1.0f / L[nq][0];
        float ss = 0.f;
#pragma unroll
        for (int md = 0; md < 4; ++md) { O[md][nq] = O[md][nq] * inv; const f32x4 x = O[md][nq]; ss += (x[0] * x[0] + x[1] * x[1]) + (x[2] * x[2] + x[3] * x[3]); }
        ss += __shfl_xor(ss, 16); ss += __shfl_xor(ss, 32);
        if (fq3 == 0) (void)__hip_atomic_fetch_add(gp(ssq) + tok0 + 128 * nq + fr3, ss, __ATOMIC_RELAXED, __HIP_MEMORY_SCOPE_AGENT);
#pragma unroll
        for (int md = 0; md < 4; ++md) {
            const f32x4 y = O[md][nq];
            u32x2 w; w.x = cvtpk(y[0], y[1]); w.y = cvtpk(y[2], y[3]);
            *(GAS u32x2*)(YMIX + (tok0 + 128 * nq + fr3) * D + h * 64 + 16 * md + 4 * fq3) = w;
        }
    }
    __syncthreads();
}

__device__ __forceinline__ void conv_unit(const bf16* PROJ, bf16* YMIX, const float* w_conv, const float* b_conv, const float* g_conv, int b, int c, int wave, int lane_in) {
    {
        const int lane2 = launder_v(lane_in); wave = launder_s(wave);
        const int ch0 = 8 * lane2;
        float w0[8], w1[8], w2[8], bc[8], gc[8];
#pragma unroll
        for (int e = 0; e < 8; ++e) { w0[e] = gp(w_conv)[ch0 + e]; w1[e] = gp(w_conv)[512 + ch0 + e]; w2[e] = gp(w_conv)[1024 + ch0 + e]; bc[e] = gp(b_conv)[ch0 + e]; gc[e] = gp(g_conv)[ch0 + e]; }
        const int s0 = c * 64 + 8 * wave;
        const bf16* rowp = PROJ + ((size_t)b * SEQ + s0) * NPROJ + ch0;
        u32x4 xa[10], ga[10], gb[8];
#pragma unroll
        for (int r = 0; r < 10; ++r) { if (r >= 2 || s0 >= 2) { xa[r] = *(const GAS u32x4*)(rowp + (r - 2) * NPROJ + 1536); ga[r] = *(const GAS u32x4*)(rowp + (r - 2) * NPROJ + 2560); }
            else { xa[r] = (u32x4){0u, 0u, 0u, 0u}; ga[r] = xa[r]; } }
#pragma unroll
        for (int r = 0; r < 8; ++r) gb[r] = *(const GAS u32x4*)(rowp + r * NPROJ + 2048);
#define CV_U(dst, xv, gv) do { dst[0] = bf_lo(xv.x) * bf_lo(gv.x); dst[1] = bf_hi(xv.x) * bf_hi(gv.x); dst[2] = bf_lo(xv.y) * bf_lo(gv.y); dst[3] = bf_hi(xv.y) * bf_hi(gv.y); \
        dst[4] = bf_lo(xv.z) * bf_lo(gv.z); dst[5] = bf_hi(xv.z) * bf_hi(gv.z); dst[6] = bf_lo(xv.w) * bf_lo(gv.w); dst[7] = bf_hi(xv.w) * bf_hi(gv.w); } while (0)
        float u0[8], u1[8];
        CV_U(u0, xa[0], ga[0]); CV_U(u1, xa[1], ga[1]);
#pragma unroll
        for (int r = 0; r < 8; ++r) {
            float u2[8]; CV_U(u2, xa[r + 2], ga[r + 2]);
            const u32x4 gbv = gb[r];
            float gbf[8] = {bf_lo(gbv.x), bf_hi(gbv.x), bf_lo(gbv.y), bf_hi(gbv.y), bf_lo(gbv.z), bf_hi(gbv.z), bf_lo(gbv.w), bf_hi(gbv.w)};
            float y[8]; float ss = 0.f;
#pragma unroll
            for (int e = 0; e < 8; ++e) { y[e] = gbf[e] * (w0[e] * u0[e] + w1[e] * u1[e] + w2[e] * u2[e] + bc[e]); ss += y[e] * y[e]; }
            const float rstd = 1.0f / sqrtf(wave_sum(ss) * (1.0f / 512.0f) + EPS);
            u32x4 o;
            o.x = cvtpk(y[0] * rstd * gc[0], y[1] * rstd * gc[1]); o.y = cvtpk(y[2] * rstd * gc[2], y[3] * rstd * gc[3]);
            o.z = cvtpk(y[4] * rstd * gc[4], y[5] * rstd * gc[5]); o.w = cvtpk(y[6] * rstd * gc[6], y[7] * rstd * gc[7]);
            *(GAS u32x4*)(YMIX + ((size_t)b * SEQ + s0 + r) * D + 512 + ch0) = o;
#pragma unroll
            for (int e = 0; e < 8; ++e) { u0[e] = u1[e]; u1[e] = u2[e]; }
        }
#undef CV_U
    }
}

#define XB_TMO      128
#define XB_XCNT(j)  (256  + 64 * (j))
#define XB_XSUB(j)  (1280 + 64 * (j))
#define XB_XGEN(j)  (2304 + 64 * (j))
#define XB_TOP      3328
#define XB_TOPGEN   3392
#define XCD_BAR_WORDS 3456
#define XB_SPIN_CAP (1u << 18)

__device__ __forceinline__ unsigned xb_ld(unsigned* p)              { return __hip_atomic_load(p, __ATOMIC_RELAXED, __HIP_MEMORY_SCOPE_AGENT); }
__device__ __forceinline__ unsigned xb_add(unsigned* p, unsigned v) { return __hip_atomic_fetch_add(p, v, __ATOMIC_RELAXED, __HIP_MEMORY_SCOPE_AGENT); }
__device__ __forceinline__ unsigned xb_xcc_id() { return (unsigned)__builtin_amdgcn_s_getreg((3 << 11) | 20) & 0xFu; }
#define XB_SPIN(cond, bar) do { unsigned _sp = 0; while (cond) { __builtin_amdgcn_s_sleep(1); \
    if ((++_sp & 255u) == 0u) { if (xb_ld(&(bar)[XB_TMO])) break; if (_sp > XB_SPIN_CAP) { atomicAdd(&(bar)[XB_TMO], 1u); break; } } } } while (0)

struct XcdBarrier {
    unsigned* bar; unsigned x;
    volatile LAS unsigned* st;
};

__device__ __forceinline__ XcdBarrier xcd_barrier_post(unsigned* bar, volatile LAS unsigned* st) {
    XcdBarrier b; b.bar = bar; b.x = xb_xcc_id(); b.st = st;
    if (threadIdx.x == 0) (void)xb_add(&bar[XB_XCNT(b.x)], 1u);
    return b;
}
__device__ __forceinline__ void xcd_barrier_complete(unsigned* bar, unsigned x, unsigned& nloc, unsigned& nx) {
    const unsigned G = gridDim.x * gridDim.y * gridDim.z;
    unsigned sum, cnt, mine, sp = 0u;
    for (;;) {
        sum = 0u; cnt = 0u;
#pragma unroll
        for (unsigned j = 0; j < 16; ++j) { const unsigned c = xb_ld(&bar[XB_XCNT(j)]); sum += c; cnt += (c > 0u) ? 1u : 0u; }
        mine = xb_ld(&bar[XB_XCNT(x)]);
        if (sum == G) break;
        __builtin_amdgcn_s_sleep(1);
        if ((++sp & 255u) == 0u) { if (xb_ld(&bar[XB_TMO])) break; if (sp > XB_SPIN_CAP) { atomicAdd(&bar[XB_TMO], 1u); break; } }
    }
    nloc = mine > 0u ? mine : 1u; nx = cnt > 0u ? cnt : 1u;
}

__device__ __forceinline__ void xcd_barrier(const XcdBarrier& b_in, const bool is_t0) {
    XcdBarrier b = b_in; b.x = (unsigned)launder_s(__builtin_amdgcn_readfirstlane((int)b_in.x)); b.bar = launder(b_in.bar);
    asm volatile("s_waitcnt vmcnt(0)" ::: "memory");
    __syncthreads();
    if (is_t0) {
        unsigned* bar = b.bar;
        __builtin_amdgcn_s_waitcnt(0);
        unsigned nloc = b.st[0], nx = b.st[1];
        if (nloc == 0u) { xcd_barrier_complete(bar, b.x, nloc, nx); b.st[0] = nloc; b.st[1] = nx; }
        const unsigned old = xb_add(&bar[XB_XSUB(b.x)], 1u);
        const unsigned gen = old / nloc;
        if (old + 1u == (gen + 1u) * nloc) {
            __builtin_amdgcn_fence(__ATOMIC_RELEASE, "agent");
            asm volatile("s_waitcnt vmcnt(0)" ::: "memory");
            const unsigned og = xb_add(&bar[XB_TOP], 1u);
            const unsigned tg = og / nx;
            if (og + 1u == (tg + 1u) * nx) xb_add(&bar[XB_TOPGEN], 1u);
            else XB_SPIN(xb_ld(&bar[XB_TOPGEN]) == tg, bar);
            __builtin_amdgcn_fence(__ATOMIC_ACQUIRE, "agent");
            xb_add(&bar[XB_XGEN(b.x)], 1u);
            asm volatile("s_waitcnt vmcnt(0)" ::: "memory");
        } else {
            XB_SPIN(xb_ld(&bar[XB_XGEN(b.x)]) == gen, bar);
            __builtin_amdgcn_fence(__ATOMIC_ACQUIRE, "agent");
            asm volatile("s_waitcnt vmcnt(0)" ::: "memory");
        }
    }
    __syncthreads();
}

struct Args {
    const float *x, *c, *w_ada, *b_ada, *g_norm, *w_ffn1_in, *w_ffn1_out, *w_in, *q_norm_g, *k_norm_g, *rel_bias, *w_conv, *b_conv, *g_attn_out, *g_conv_out, *w_out, *w_ffn2_in, *w_ffn2_out, *g_final;
    float* out; unsigned char* ws;
    int rep_norm, rep_up, rep_proj, rep_att, rep_conv, rep_res0, rep_sync, pad;
};

__global__ void __launch_bounds__(NWAVES * 64, 2) fwd_megakernel(Args a_unused) {
#define KARG(f) (kargp[opaque_zero()].f)
    typedef const __attribute__((address_space(4))) Args* kargp_t;
    const kargp_t kargp = (kargp_t)__builtin_amdgcn_kernarg_segment_ptr();
    extern __shared__ __attribute__((aligned(16))) unsigned char lds_raw[];
    cg::grid_group grid = cg::this_grid();
    LAS unsigned char* lds = (LAS unsigned char*)lds_raw;
    const int wave = __builtin_amdgcn_readfirstlane((int)threadIdx.x >> 6);
#define FRESH_LANE() fresh_lane()
#define FRESH_TID() (launder_s(wave) * 64 + fresh_lane())
    constexpr int G = 256; const int bx = blockIdx.x;
    const int gw = bx * NWAVES + wave, NGW = G * NWAVES;
    unsigned char* ws = KARG(ws);
    float* mod = (float*)(ws + WS_MOD);
#define GRID_BAR() xcd_barrier(xbar, FRESH_TID() == 0)
    volatile LAS unsigned* bst = (volatile LAS unsigned*)(lds + 131072 + 64);
    { const int t0 = FRESH_TID(); if (t0 < 2) bst[t0] = 0u; }
    __syncthreads();
    const XcdBarrier xbar = xcd_barrier_post((unsigned*)(ws + WS_BAR), bst);

    {
        const int it = wave * G + bx;
        if (wave < 3 && it < 16 * 36) mod_item(KARG(c), KARG(w_ada), KARG(b_ada), mod, it, FRESH_LANE());
    }
    if (KARG(rep_sync) < 0) grid.sync();
    GRID_BAR();
    {
        constexpr int I_IN = (D / 64) * (2 * DFF / 32), I_OUT = (DFF / 64) * (D / 32), I_PROJ = (D / 64) * (NPROJ / 32), I_WO = (D / 64) * (D / 32);
        constexpr int NITEMS = 2 * I_IN + 2 * I_OUT + I_PROJ + I_WO;
        LAS float* scr = (LAS float*)(lds + wave * 16384); const int lane = FRESH_LANE();
        for (int it = gw; it < NITEMS; it += NGW) {
            int r = it;
            if (r < 2 * I_IN) { const int f = r >= I_IN; r -= f * I_IN; const int nblk = 2 * DFF / 32, kb = r / nblk, nb = r % nblk;
                transpose_item(f ? KARG(w_ffn2_in) : KARG(w_ffn1_in), D, 2 * DFF, (bf16*)(ws + (f ? WS_W2IN : WS_W1IN)), 64 * kb, 32 * nb, drow_swiglu(32 * nb), scr, lane); continue; } r -= 2 * I_IN;
            if (r < 2 * I_OUT) { const int f = r >= I_OUT; r -= f * I_OUT; const int nblk = D / 32, kb = r / nblk, nb = r % nblk;
                transpose_item(f ? KARG(w_ffn2_out) : KARG(w_ffn1_out), DFF, D, (bf16*)(ws + (f ? WS_W2OUT : WS_W1OUT)), 64 * kb, 32 * nb, drow_plain(32 * nb), scr, lane); continue; } r -= 2 * I_OUT;
            if (r < I_PROJ) { const int nblk = NPROJ / 32, kb = r / nblk, nb = r % nblk;
                transpose_item(KARG(w_in), D, NPROJ, (bf16*)(ws + WS_WIN), 64 * kb, 32 * nb, drow_proj(32 * nb), scr, lane); continue; } r -= I_PROJ;
            { const int nblk = D / 32, kb = r / nblk, nb = r % nblk;
                transpose_item(KARG(w_out), D, D, (bf16*)(ws + WS_WOUT), 64 * kb, 32 * nb, drow_plain(32 * nb), scr, lane, kb < 8 ? KARG(g_attn_out) : nullptr); }
        }
    }

    for (int step = 0; step < 3; ++step) {
        unsigned char* wsl = launder(ws);
        float* modl = (float*)(wsl + WS_MOD);
        {
            bf16* XNl = (bf16*)(wsl + WS_XN); const int ln = FRESH_LANE();
            if (step == 0) { const float* xin = launder(KARG(x));
                for (int rep = 0; rep < KARG(rep_norm); ++rep)
                for (int it = 0, m = gw; it < M / (4 * NGW); ++it, m += 4 * NGW) {
                    const float* mb = modl + (m >> 13) * NMOD + step * 3072;
                    norm_rows_bf16<4>(xin, XNl, m, NGW, KARG(g_norm) + step * D, mb, mb + 1024, ln); }
            }
        }
        if (step == 0) GRID_BAR();
        const bf16* A2; const bf16* B2; int K2;
        if (step != 1) {
            unsigned char* w2 = launder(wsl);
            pg8::Gemm g{(const bf16*)(w2 + (step == 0 ? WS_XN : WS_XN2)), (const bf16*)(w2 + (step == 0 ? WS_W1IN : WS_W2IN)), M, 2 * DFF, D}; pg8::StaticOrder S; S.init(M, 2 * DFF, G, bx);
            pg8::EpiSwiglu E{(bf16*)(w2 + WS_ACT), DFF};
            for (int rep = 0; rep < KARG(rep_up); ++rep)
            pg8::gemm_phase<pg8::EpiSwiglu, pg8::StaticOrder, true, true>(lds, g, S, E, FRESH_TID());
            GRID_BAR();
            A2 = (const bf16*)(wsl + WS_ACT); B2 = (const bf16*)(wsl + (step == 0 ? WS_W1OUT : WS_W2OUT)); K2 = DFF;
        } else {
            {
                unsigned char* w2 = launder(wsl);
                pg8::Gemm g{(const bf16*)(w2 + WS_XN), (const bf16*)(w2 + WS_WIN), M, NPROJ, D}; pg8::StaticOrder S; S.init(M, NPROJ, G, bx);
                pg8::EpiProj E{(bf16*)(w2 + WS_ACT), KARG(q_norm_g), KARG(k_norm_g)};
                for (int rep = 0; rep < KARG(rep_proj); ++rep)
                pg8::gemm_phase<pg8::EpiProj, pg8::StaticOrder, true, true>(lds, g, S, E, FRESH_TID());
            }
            GRID_BAR();
            {
                unsigned char* w2 = launder(wsl); const int ln = FRESH_LANE();
                const int vcu = (G % 8 == 0) ? (bx % 8) * (G / 8) + bx / 8 : bx;
                float* ssq = (float*)(w2 + WS_SSQ);
                attn_bias_table(lds, KARG(rel_bias), KARG(q_norm_g), KARG(k_norm_g), ((vcu * 4) >> 4) & 7, FRESH_LANE(), FRESH_TID());
                for (int rep = 0; rep < KARG(rep_att); ++rep)
                for (int j = 0; j < 4; ++j) {
                    const int uu = vcu * 4 + j;
                    attn_unit(lds, (const bf16*)(w2 + WS_ACT), (bf16*)(w2 + WS_XN), rep == 0 ? ssq : ssq + M, KARG(rel_bias), KARG(q_norm_g), KARG(k_norm_g), uu >> 7, (uu >> 4) & 7, 8 * (uu & 15), wave, FRESH_LANE(), FRESH_TID());
                }
                for (int rep = 0; rep < KARG(rep_conv); ++rep)
                for (int uu = vcu * 4; uu < vcu * 4 + 4; ++uu)
                    conv_unit((const bf16*)(w2 + WS_ACT), (bf16*)(w2 + WS_XN), KARG(w_conv), KARG(b_conv), KARG(g_conv_out), uu >> 7, uu & 127, wave, FRESH_LANE());
            }
            GRID_BAR();
            A2 = (const bf16*)(wsl + WS_XN); B2 = (const bf16*)(wsl + WS_WOUT); K2 = D;
        }
        {
            pg8::Gemm g{launder(A2), launder(B2), M, D, K2}; pg8::StaticOrder S; S.init(M, D, G, bx);
            pg8::EpiResid E{launder(KARG(x)), (bf16*)(wsl + WS_XS), launder(modl), (const float*)(wsl + WS_SSQ), step < 2 ? KARG(g_norm) + (step + 1) * D : KARG(g_final),
                            (bf16*)(wsl + (step == 0 ? WS_XN : WS_XN2)), launder(KARG(out)), (float*)(wsl + WS_XBUF) + (size_t)step * M * 4, (unsigned*)(wsl + WS_CNT) + step * 256, lds + 131072 + 1024, step, step == 1 ? 8 : -1};
            for (int rep = 0; rep < (step == 0 ? KARG(rep_res0) : 1); ++rep)
            pg8::gemm_phase<pg8::EpiResid, pg8::StaticOrder, true, true>(lds, g, S, E, FRESH_TID());
        }
        if (step < 2) GRID_BAR();
        for (int rep = 0; rep < KARG(rep_sync); ++rep) GRID_BAR();
    }
}

extern "C" void kernel_launch(void* const* d_in, const int* in_sizes, int n_in, void* d_out, int out_size, void* d_ws, size_t ws_size, hipStream_t stream) {
    static int grid = 0;
    if (grid == 0) {
        if (n_in != 19 || out_size != M * D || ws_size < WS_END) { fprintf(stderr, "kernel_launch: unexpected shapes (n_in %d out %d ws %zu)\n", n_in, out_size, ws_size); grid = -1; return; }
        int dev = 0, cus = 0, per_cu = 0;
        (void)hipGetDevice(&dev);
        (void)hipDeviceGetAttribute(&cus, hipDeviceAttributeMultiprocessorCount, dev);
        if (hipFuncSetAttribute((const void*)fwd_megakernel, hipFuncAttributeMaxDynamicSharedMemorySize, LDS_BYTES) != hipSuccess) { fprintf(stderr, "kernel_launch: hipFuncSetAttribute failed\n"); grid = -1; return; }
        if (hipOccupancyMaxActiveBlocksPerMultiprocessor(&per_cu, (const void*)fwd_megakernel, NWAVES * 64, LDS_BYTES) != hipSuccess || per_cu < 1) { fprintf(stderr, "kernel_launch: occupancy query says %d\n", per_cu); per_cu = 1; }
        (void)hipGetLastError();
        grid = cus * per_cu;
        if (grid > 256) grid = 256;
        if (grid != 256) { fprintf(stderr, "kernel_launch: this kernel is built for a 256-workgroup grid, got %d; nothing launched\n", grid); grid = -1; return; }
        fprintf(stderr, "kernel_launch: grid %d (cus %d per_cu %d)\n", grid, cus, per_cu);
    }
    if (grid < 0) return;
    (void)hipMemsetAsync((char*)d_ws + WS_MOD, 0, CTL_ZERO_BYTES, stream);
    Args a{};
    const float** ap = (const float**)&a;
    for (int i = 0; i < 19; ++i) ap[i] = (const float*)d_in[i];
    a.out = (float*)d_out; a.ws = (unsigned char*)d_ws;
    a.rep_norm = KN_NORM; a.rep_up = KN_UP; a.rep_proj = KN_PROJ; a.rep_att = KN_ATT; a.rep_conv = KN_CONV; a.rep_res0 = KN_RES0; a.rep_sync = KN_SYNC; a.pad = 0;
    void* args[] = {&a};
    hipError_t e = hipLaunchCooperativeKernel((const void*)fwd_megakernel, dim3(grid), dim3(NWAVES * 64), args, LDS_BYTES, stream);
    if (e != hipSuccess) fprintf(stderr, "cooperative launch failed: %s (grid %d)\n", hipGetErrorString(e), grid);
}
```

```cpp
#include <hip/hip_runtime.h>
#include <hip/hip_cooperative_groups.h>
#include <cstdio>
#include <cstdint>
namespace cg = cooperative_groups;
namespace pg8 {
#define PG8_LAS __attribute__((address_space(3)))
typedef unsigned short bf16_t;
typedef short bf16x8 __attribute__((ext_vector_type(8)));
typedef float f32x4 __attribute__((ext_vector_type(4)));
typedef unsigned u32x4 __attribute__((ext_vector_type(4)));
constexpr int BM = 256, BK = 64, HALF = 128, HTB = HALF * BK * 2  , STAGE_BYTES = 8 * HTB, NXCD = 8, WGM = 8;

__host__ __device__ __forceinline__ int lds_byte(int r, int c) { const int st = (r >> 4) * 2 + (c >> 5), rr = r & 15, cc = c & 31, ob = rr * 64 + cc * 2; return st * 1024 + (ob ^ (((ob >> 9) & 1) << 5)); }
__host__ __device__ __forceinline__ void stage_rc(int b, int& R, int& C) { const int st = b / 1024, sb = b % 1024, swz = sb ^ (((sb >> 9) & 1) << 5); R = (st >> 1) * 16 + swz / 64; C = (st & 1) * 32 + (swz % 64) / 2; }
__host__ __device__ __forceinline__ int perm32(int rho) { const int n = rho >> 4, i = rho & 15; return 8 * (i >> 2) + 4 * n + (i & 3); }

struct Unit { int pm, pn; };
struct Gemm { const bf16_t* A; const bf16_t* Bt; int M, N, K; };

struct StaticOrder {
    int nM, nN, nwg, G, c;
    __host__ __device__ void init(int M, int N, int G_, int c_) { nM = M / BM; nN = N / BM; nwg = nM * nN; G = G_; c = c_; }
    __host__ __device__ bool next(int i, Unit& u) const {
        const long L = (long)i * G + c; if (L >= nwg) return false;
        int wgid = (int)L; { const int q = nwg / NXCD, r = nwg % NXCD, xcd = wgid % NXCD, off = wgid / NXCD; wgid = (xcd < r ? xcd * (q + 1) : r * (q + 1) + (xcd - r) * q) + off; }
        const int nig = WGM * nN, gid = wgid / nig, fm = gid * WGM, gsz = (nM - fm) < WGM ? (nM - fm) : WGM;
        u.pm = fm + ((wgid % nig) % gsz); u.pn = (wgid % nig) / gsz; return true;
    }
    __device__ __forceinline__ void a_ready(const Unit&) const {}
    __device__ __forceinline__ void done(const Unit&) const {}
};


#define PG8_GAS __attribute__((address_space(1)))
typedef float f32x2 __attribute__((ext_vector_type(2)));
typedef __bf16 bf16x2_t __attribute__((ext_vector_type(2)));
__device__ __forceinline__ unsigned cvtpk(float lo, float hi) { f32x2 v = {lo, hi}; bf16x2_t b = __builtin_convertvector(v, bf16x2_t); return __builtin_bit_cast(unsigned, b); }
__device__ __forceinline__ float silu_mul(float g, float u) { return g * u * __builtin_amdgcn_rcpf(1.0f + __builtin_amdgcn_exp2f(-1.4426950408889634f * g)); }

struct EpiSwiglu {
    static constexpr bool PERM = true, AFTER_DRAIN = false, MIDK = false;
    bf16_t* O; int ldc;
    __device__ __forceinline__ void operator()(const f32x4 (&acc)[2][2][4][2], const Unit& u, int wr, int wc, int fr, int fq) const {
        const int row0 = u.pm * BM + wr * 64 + fr, col0 = u.pn * HALF + wc * 32 + 8 * fq;
#pragma unroll
        for (int ai = 0; ai < 2; ++ai)
#pragma unroll
            for (int m = 0; m < 4; ++m) {
                bf16_t* p = O + (size_t)(row0 + ai * HALF + m * 16) * ldc + col0;
                const f32x4 g0 = acc[ai][0][m][0], g1 = acc[ai][0][m][1], u0 = acc[ai][1][m][0], u1 = acc[ai][1][m][1];
                u32x4 w;
                w.x = cvtpk(silu_mul(g0[0], u0[0]), silu_mul(g0[1], u0[1])); w.y = cvtpk(silu_mul(g0[2], u0[2]), silu_mul(g0[3], u0[3]));
                w.z = cvtpk(silu_mul(g1[0], u1[0]), silu_mul(g1[1], u1[1])); w.w = cvtpk(silu_mul(g1[2], u1[2]), silu_mul(g1[3], u1[3]));
                __builtin_nontemporal_store(w, (PG8_GAS u32x4*)p);
            }
    }
};
struct EpiResid {
    static constexpr bool PERM = true, AFTER_DRAIN = false, MIDK = true;
    const float* xin; bf16_t* xs; const float* mod; const float* ssq; int step, midk;
    __device__ __forceinline__ void mid(f32x4 (&acc)[2][2][4][2], const Unit& u, int wr, int fr_in) const {
        int fr = fr_in; asm volatile("" : "+v"(fr));
#pragma unroll
        for (int ai = 0; ai < 2; ++ai)
#pragma unroll
            for (int m = 0; m < 4; ++m) {
                const float s = 1.0f / sqrtf(((const PG8_GAS float*)ssq)[u.pm * BM + ai * HALF + wr * 64 + m * 16 + fr] * (1.0f / 512.0f) + 1e-6f);
#pragma unroll
                for (int bj = 0; bj < 2; ++bj)
#pragma unroll
                    for (int n = 0; n < 2; ++n) acc[ai][bj][m][n] = acc[ai][bj][m][n] * s;
            }
    }
    __device__ __forceinline__ void operator()(const f32x4 (&acc)[2][2][4][2], const Unit& u, int wr, int wc, int fr, int fq) const {
        const int b = (u.pm * BM) >> 13;
        const float* gp = mod + b * 9216 + step * 3072 + 2048; const float coef = step == 1 ? 1.0f : 0.5f;
        const float* basef = step == 0 ? xin : (const float*)nullptr; const bf16_t* baseb = xs; bf16_t* out = xs;
        const int col0 = u.pn * BM + wc * 32 + 8 * fq;
        f32x4 gv[2][2];
#pragma unroll
        for (int bj = 0; bj < 2; ++bj)
#pragma unroll
            for (int n = 0; n < 2; ++n) gv[bj][n] = (*(const PG8_GAS f32x4*)(gp + col0 + bj * HALF + 4 * n) + 1.0f) * coef;
#pragma unroll
        for (int ai = 0; ai < 2; ++ai)
#pragma unroll
            for (int m = 0; m < 4; ++m) {
                const size_t off = (size_t)(u.pm * BM + ai * HALF + wr * 64 + m * 16 + fr) * 1024 + col0;
#pragma unroll
                for (int bj = 0; bj < 2; ++bj) {
                    f32x4 b0, b1;
                    if (basef) { b0 = __builtin_nontemporal_load((const PG8_GAS f32x4*)(basef + off + bj * HALF)); b1 = __builtin_nontemporal_load((const PG8_GAS f32x4*)(basef + off + bj * HALF + 4)); }
                    else { const u32x4 w = __builtin_nontemporal_load((const PG8_GAS u32x4*)(baseb + off + bj * HALF));
                        b0 = (f32x4){__uint_as_float(w.x << 16), __uint_as_float(w.x & 0xffff0000u), __uint_as_float(w.y << 16), __uint_as_float(w.y & 0xffff0000u)};
                        b1 = (f32x4){__uint_as_float(w.z << 16), __uint_as_float(w.z & 0xffff0000u), __uint_as_float(w.w << 16), __uint_as_float(w.w & 0xffff0000u)}; }
                    const f32x4 o0 = b0 + gv[bj][0] * acc[ai][bj][m][0], o1 = b1 + gv[bj][1] * acc[ai][bj][m][1];
                    u32x4 w; w.x = cvtpk(o0[0], o0[1]); w.y = cvtpk(o0[2], o0[3]); w.z = cvtpk(o1[0], o1[1]); w.w = cvtpk(o1[2], o1[3]);
                    __builtin_nontemporal_store(w, (PG8_GAS u32x4*)(out + off + bj * HALF));
                }
            }
    }
};
struct EpiProj {
    static constexpr bool PERM = true, AFTER_DRAIN = false, MIDK = false;
    bf16_t* O; const float* gq; const float* gk;
    __device__ __forceinline__ void operator()(const f32x4 (&acc)[2][2][4][2], const Unit& u, int wr, int wc, int fr, int fq) const {
        const int row0 = u.pm * BM + wr * 64 + fr, colh = u.pn * BM + wc * 64 + 8 * fq;
        if (u.pn < 4) {
            const float* g = (u.pn < 2) ? gq : gk; const float sc = (u.pn < 2) ? 0.125f * 1.4426950408889634f : 1.0f;
            f32x4 gv[2][2];
#pragma unroll
            for (int bj = 0; bj < 2; ++bj)
#pragma unroll
                for (int n = 0; n < 2; ++n) gv[bj][n] = *(const PG8_GAS f32x4*)(g + 32 * bj + 8 * fq + 4 * n) * sc;
#pragma unroll
            for (int ai = 0; ai < 2; ++ai)
#pragma unroll
                for (int m = 0; m < 4; ++m) {
                    float ss = 0.f;
#pragma unroll
                    for (int bj = 0; bj < 2; ++bj)
#pragma unroll
                        for (int n = 0; n < 2; ++n) { const f32x4 x = acc[ai][bj][m][n]; ss += (x[0] * x[0] + x[1] * x[1]) + (x[2] * x[2] + x[3] * x[3]); }
                    ss += __shfl_xor(ss, 16); ss += __shfl_xor(ss, 32);
                    const float rstd = 1.0f / sqrtf(ss * (1.0f / 64.0f) + 1e-6f);
                    bf16_t* p = O + (size_t)(row0 + ai * HALF + m * 16) * 3072 + colh;
#pragma unroll
                    for (int bj = 0; bj < 2; ++bj) {
                        const f32x4 v0 = acc[ai][bj][m][0] * rstd * gv[bj][0], v1 = acc[ai][bj][m][1] * rstd * gv[bj][1];
                        u32x4 w; w.x = cvtpk(v0[0], v0[1]); w.y = cvtpk(v0[2], v0[3]); w.z = cvtpk(v1[0], v1[1]); w.w = cvtpk(v1[2], v1[3]);
                        __builtin_nontemporal_store(w, (PG8_GAS u32x4*)(p + 32 * bj));
                    }
                }
        } else {
#pragma unroll
            for (int ai = 0; ai < 2; ++ai)
#pragma unroll
                for (int m = 0; m < 4; ++m) {
                    bf16_t* p = O + (size_t)(row0 + ai * HALF + m * 16) * 3072 + colh;
#pragma unroll
                    for (int bj = 0; bj < 2; ++bj) {
                        const f32x4 v0 = acc[ai][bj][m][0], v1 = acc[ai][bj][m][1];
                        u32x4 w; w.x = cvtpk(v0[0], v0[1]); w.y = cvtpk(v0[2], v0[3]); w.z = cvtpk(v1[0], v1[1]); w.w = cvtpk(v1[2], v1[3]);
                        __builtin_nontemporal_store(w, (PG8_GAS u32x4*)(p + 32 * bj));
                    }
                }
        }
    }
};

template <class Epi, class Sched, bool ALIGN_EPI = false, bool SP2 = false>
__device__ __forceinline__ void gemm_phase(PG8_LAS unsigned char* lds, const Gemm g, const Sched& S, const Epi& E, const int tid) {
    const int  wid = __builtin_amdgcn_readfirstlane(tid >> 6), lane = tid & 63, wr = wid >> 2, wc = wid & 3, fr = lane & 15, fq = lane >> 4;
    const int K = g.K, nt = K / BK;
    unsigned voffA[2], voffB[2];
#pragma unroll
    for (int i = 0; i < 2; ++i) { int R, C; stage_rc(tid * 16 + i * 8192, R, C); const int Rb = Epi::PERM ? ((R & ~31) + perm32(R & 31)) : R;
        voffA[i] = (unsigned)(R * K + C) * 2u; voffB[i] = (unsigned)(Rb * K + C) * 2u; }
    const size_t kstep = (size_t)(BK * 2);
    const size_t hstep = (size_t)HALF * K * 2;
    const size_t tstep = 2 * hstep;
    const unsigned ldsw = (unsigned)wid * 1024u;
    const int aoff = lds_byte(wr * 64 + fr, fq * 8), boff = lds_byte(wc * 32 + fr, fq * 8);
#define PG8_SA(b, h) (((b) * 2 + (h)) * HTB)
#define PG8_SB(b, h) ((4 + (b) * 2 + (h)) * HTB)
#define PG8_STAGE(bufoff, gbase, voff) do { _Pragma("unroll") for (int _i = 0; _i < 2; ++_i) \
        __builtin_amdgcn_global_load_lds((const unsigned*)((const char*)(gbase) + (voff)[_i]), (PG8_LAS unsigned*)(lds + (bufoff) + ldsw + _i * 8192), 16, 0, 0); } while (0)
#define PG8_LDA(dst, b, h) do { _Pragma("unroll") for (int m = 0; m < 4; ++m) _Pragma("unroll") for (int k = 0; k < 2; ++k) dst[m][k] = *(const PG8_LAS bf16x8*)(lds + PG8_SA(b, h) + aoff + m * 2048 + k * 1024); } while (0)
#define PG8_LDB(dst, b, h) do { _Pragma("unroll") for (int n = 0; n < 2; ++n) _Pragma("unroll") for (int k = 0; k < 2; ++k) dst[n][k] = *(const PG8_LAS bf16x8*)(lds + PG8_SB(b, h) + boff + n * 2048 + k * 1024); } while (0)
#define PG8_MMA(ai, bj, At, Bt) do { __builtin_amdgcn_s_setprio(1); _Pragma("unroll") for (int m = 0; m < 4; ++m) _Pragma("unroll") for (int n = 0; n < 2; ++n) _Pragma("unroll") for (int k = 0; k < 2; ++k) \
        acc[ai][bj][m][n] = __builtin_amdgcn_mfma_f32_16x16x32_bf16(Bt[n][k], At[m][k], acc[ai][bj][m][n], 0, 0, 0); __builtin_amdgcn_s_setprio(0); } while (0)
#define PG8_WAIT_V(n) asm volatile("s_waitcnt vmcnt(" #n ")" ::: "memory")
#define PG8_WAIT_L(n) asm volatile("s_waitcnt lgkmcnt(" #n ")" ::: "memory")
#define PG8_BAR __builtin_amdgcn_s_barrier()
#define PG8_SCHED __builtin_amdgcn_sched_barrier(0)
    Unit cur, nxt; int ui = 0;
    if (!S.next(0, cur)) return;
    f32x4 acc[2][2][4][2];
#pragma unroll
    for (int a = 0; a < 2; ++a)
#pragma unroll
        for (int b = 0; b < 2; ++b)
#pragma unroll
            for (int m = 0; m < 4; ++m)
#pragma unroll
                for (int n = 0; n < 2; ++n) acc[a][b][m][n] = (f32x4){0.f, 0.f, 0.f, 0.f};
    bf16x8 At[4][2], B0[2][2], B1[2][2];
    const char* cA = (const char*)g.A + (size_t)cur.pm * tstep; const char* cB = (const char*)g.Bt + (size_t)cur.pn * tstep;
    S.a_ready(cur);
    if constexpr (SP2) {
        PG8_STAGE(PG8_SB(0, 0), cB, voffB); PG8_STAGE(PG8_SB(0, 1), cB + hstep, voffB); PG8_STAGE(PG8_SA(0, 0), cA, voffA); PG8_STAGE(PG8_SA(0, 1), cA + hstep, voffA);
        if (wr == 1) PG8_BAR;
        PG8_WAIT_V(2); PG8_BAR;
        PG8_STAGE(PG8_SB(1, 0), cB + kstep, voffB); PG8_STAGE(PG8_SA(1, 0), cA + kstep, voffA); PG8_STAGE(PG8_SB(1, 1), cB + hstep + kstep, voffB);
        PG8_WAIT_V(6); PG8_BAR;
    } else {
        PG8_STAGE(PG8_SB(0, 0), cB, voffB); PG8_STAGE(PG8_SA(0, 0), cA, voffA); PG8_STAGE(PG8_SB(0, 1), cB + hstep, voffB); PG8_STAGE(PG8_SA(0, 1), cA + hstep, voffA);
        if (wr == 1) PG8_BAR;
        PG8_WAIT_V(4); PG8_BAR;
        PG8_STAGE(PG8_SB(1, 0), cB + kstep, voffB); PG8_STAGE(PG8_SA(1, 0), cA + kstep, voffA); PG8_STAGE(PG8_SB(1, 1), cB + hstep + kstep, voffB);
        PG8_WAIT_V(6); PG8_BAR;
    }
    for (;;) {
        const bool has_next = S.next(ui + 1, nxt);
        const char* nA = has_next ? (const char*)g.A + (size_t)nxt.pm * tstep : cA; const char* nB = has_next ? (const char*)g.Bt + (size_t)nxt.pn * tstep : cB;
        for (int t = 0; t < nt; t += 2) {
            if constexpr (Epi::MIDK) { if (t == E.midk) E.mid(acc, cur, wr, fr); }
            const bool last = (t == nt - 2);
            const char* a1 = cA + (size_t)(t + 1) * kstep;
            const char* a2 = last ? nA : cA + (size_t)(t + 2) * kstep; const char* b2 = last ? nB : cB + (size_t)(t + 2) * kstep;
            const char* a3 = a2 + kstep; const char* b3 = b2 + kstep;
            if (last && has_next) S.a_ready(nxt);
            if constexpr (SP2) {
            PG8_LDB(B0, 0, 0); PG8_LDB(B1, 0, 1); PG8_SCHED; PG8_LDA(At, 0, 0); PG8_STAGE(PG8_SA(1, 1), a1 + hstep, voffA);
            PG8_WAIT_V(8); PG8_WAIT_L(0); PG8_BAR; PG8_MMA(0, 0, At, B0); PG8_MMA(0, 1, At, B1); PG8_BAR; PG8_SCHED;
            PG8_LDA(At, 0, 1); PG8_STAGE(PG8_SB(0, 0), b2, voffB); PG8_STAGE(PG8_SB(0, 1), b2 + hstep, voffB); PG8_STAGE(PG8_SA(0, 0), a2, voffA);
            PG8_WAIT_V(8); PG8_WAIT_L(0); PG8_BAR; PG8_MMA(1, 0, At, B0); PG8_MMA(1, 1, At, B1); PG8_BAR; PG8_SCHED;
            PG8_LDB(B0, 1, 0); PG8_LDB(B1, 1, 1); PG8_SCHED; PG8_LDA(At, 1, 0); PG8_STAGE(PG8_SA(0, 1), a2 + hstep, voffA);
            PG8_WAIT_V(8); PG8_WAIT_L(0); PG8_BAR; PG8_MMA(0, 0, At, B0); PG8_MMA(0, 1, At, B1); PG8_BAR; PG8_SCHED;
            PG8_LDA(At, 1, 1); PG8_STAGE(PG8_SB(1, 0), b3, voffB); PG8_STAGE(PG8_SB(1, 1), b3 + hstep, voffB); PG8_STAGE(PG8_SA(1, 0), a3, voffA);
            PG8_WAIT_V(8); PG8_WAIT_L(0); PG8_BAR; PG8_MMA(1, 0, At, B0); PG8_MMA(1, 1, At, B1); PG8_BAR; PG8_SCHED;
            } else {
            PG8_LDB(B0, 0, 0); PG8_SCHED; PG8_LDA(At, 0, 0); PG8_STAGE(PG8_SA(1, 1), a1 + hstep, voffA);
            PG8_WAIT_L(8); PG8_BAR; PG8_WAIT_L(0); PG8_MMA(0, 0, At, B0); PG8_BAR; PG8_SCHED;
            PG8_LDB(B1, 0, 1); PG8_STAGE(PG8_SB(0, 0), b2, voffB);
            PG8_BAR; PG8_WAIT_L(0); PG8_MMA(0, 1, At, B1); PG8_BAR;
            PG8_LDA(At, 0, 1); PG8_STAGE(PG8_SA(0, 0), a2, voffA);
            PG8_BAR; PG8_WAIT_L(0); PG8_MMA(1, 0, At, B0); PG8_BAR; PG8_SCHED;
            PG8_STAGE(PG8_SB(0, 1), b2 + hstep, voffB);
            PG8_WAIT_V(6); PG8_BAR; PG8_MMA(1, 1, At, B1); PG8_BAR;
            PG8_LDB(B0, 1, 0); PG8_SCHED; PG8_LDA(At, 1, 0); PG8_STAGE(PG8_SA(0, 1), a2 + hstep, voffA);
            PG8_WAIT_L(8); PG8_BAR; PG8_WAIT_L(0); PG8_MMA(0, 0, At, B0); PG8_BAR; PG8_SCHED;
            PG8_LDB(B1, 1, 1); PG8_STAGE(PG8_SB(1, 0), b3, voffB);
            PG8_BAR; PG8_WAIT_L(0); PG8_MMA(0, 1, At, B1); PG8_BAR;
            PG8_LDA(At, 1, 1); PG8_STAGE(PG8_SA(1, 0), a3, voffA);
            PG8_BAR; PG8_WAIT_L(0); PG8_MMA(1, 0, At, B0); PG8_BAR; PG8_SCHED;
            PG8_STAGE(PG8_SB(1, 1), b3 + hstep, voffB);
            PG8_WAIT_V(6); PG8_BAR; PG8_MMA(1, 1, At, B1); PG8_BAR;
            }
        }
        if constexpr (ALIGN_EPI) { if (wr == 0) PG8_BAR; }
        if constexpr (!Epi::AFTER_DRAIN) { E(acc, cur, wr, wc, fr, fq); S.done(cur); }
        if (!has_next) break;
#pragma unroll
        for (int a = 0; a < 2; ++a)
#pragma unroll
            for (int b = 0; b < 2; ++b)
#pragma unroll
                for (int m = 0; m < 4; ++m)
#pragma unroll
                    for (int n = 0; n < 2; ++n) acc[a][b][m][n] = (f32x4){0.f, 0.f, 0.f, 0.f};
        cur = nxt; cA = nA; cB = nB; ++ui;
        if constexpr (ALIGN_EPI) { if (wr == 1) PG8_BAR; }
    }
    PG8_WAIT_V(0);
    if constexpr (!ALIGN_EPI) { if (wr == 0) PG8_BAR; }
    PG8_BAR;
    if constexpr (Epi::AFTER_DRAIN) { E.fused(acc, cur, wr, wc, fr, fq, lds, wid, lane); S.done(cur); }
#undef PG8_SA
#undef PG8_SB
#undef PG8_STAGE
#undef PG8_LDA
#undef PG8_LDB
#undef PG8_MMA
#undef PG8_WAIT_V
#undef PG8_WAIT_L
#undef PG8_BAR
#undef PG8_SCHED
}
}

#define LAS __attribute__((address_space(3)))
typedef unsigned short bf16;
typedef float f32x4 __attribute__((ext_vector_type(4)));
typedef short bf16x8 __attribute__((ext_vector_type(8)));
typedef unsigned u32x4 __attribute__((ext_vector_type(4)));
typedef unsigned u32x2 __attribute__((ext_vector_type(2)));
using pg8::cvtpk;

#ifndef KN_NORM
#define KN_NORM 1
#endif
#ifndef KN_UP
#define KN_UP 1
#endif
#ifndef KN_PROJ
#define KN_PROJ 1
#endif
#ifndef KN_ATT
#define KN_ATT 1
#endif
#ifndef KN_CONV
#define KN_CONV 1
#endif
#ifndef KN_RES0
#define KN_RES0 1
#endif
#ifndef KN_SYNC
#define KN_SYNC 0
#endif
constexpr int NWAVES = 8;
constexpr int BATCH = 8, SEQ = 8192, D = 1024, DFF = 2816, NPROJ = 3072, M = BATCH * SEQ;
constexpr int NMOD = 9216;
constexpr float EPS = 1e-6f;
constexpr float L2E = 1.4426950408889634f;
constexpr int LDS_BYTES = 147456;

constexpr size_t MiB = 1u << 20;
constexpr size_t WS_MOD = 0;
constexpr size_t MOD_BYTES = (size_t)BATCH * NMOD * 4;
constexpr size_t WS_BAR = 512 * 1024;
constexpr size_t WS_SSQ = 576 * 1024;
constexpr size_t CTL_ZERO_BYTES = 1 * MiB;
constexpr size_t WS_W1IN = 2 * MiB, WS_W1OUT = 13 * MiB, WS_WIN = 19 * MiB, WS_WOUT = 25 * MiB, WS_W2IN = 27 * MiB, WS_W2OUT = 38 * MiB;
constexpr size_t WS_XN = 64 * MiB;
constexpr size_t WS_ACT = 192 * MiB;
constexpr size_t WS_XS = 576 * MiB;
constexpr size_t WS_END = 704 * MiB;

__device__ __forceinline__ int fresh_lane() { int z = 0; asm volatile("" : "+v"(z)); return (int)__builtin_amdgcn_mbcnt_hi(~0u, __builtin_amdgcn_mbcnt_lo(~0u, (unsigned)z)); }
__device__ __forceinline__ int launder_s(int v) { asm volatile("" : "+s"(v)); return v; }
__device__ __forceinline__ int launder_v(int v) { asm volatile("" : "+v"(v)); return v; }
__device__ __forceinline__ int opaque_zero() { int z = 0; asm volatile("" : "+s"(z)); return z; }
template <class T> __device__ __forceinline__ T* launder(T* p) { asm volatile("" : "+s"(p)); return p; }
#define GAS __attribute__((address_space(1)))
template <class T> __device__ __forceinline__ GAS T* gp(T* p) { return (GAS T*)p; }
__device__ __forceinline__ float wave_sum(float v) {
#pragma unroll
    for (int o = 1; o < 64; o <<= 1) v += __shfl_xor(v, o);
    return v;
}
__device__ __forceinline__ float wave_max(float v) {
#pragma unroll
    for (int o = 1; o < 64; o <<= 1) v = fmaxf(v, __shfl_xor(v, o));
    return v;
}
__device__ __forceinline__ float bf_lo(unsigned w) { return __uint_as_float(w << 16); }
__device__ __forceinline__ float bf_hi(unsigned w) { return __uint_as_float(w & 0xffff0000u); }

__device__ __forceinline__ void transpose_item(const float* W, int K, int N, bf16* WT, int k0, int n0, int drow0, LAS float* scr, int lane, const float* kscale = nullptr) {
    {
        f32x4 w[8]; const int c4 = lane & 7, r8 = lane >> 3;
#pragma unroll
        for (int i = 0; i < 8; ++i) w[i] = *(const GAS f32x4*)(W + (size_t)(k0 + 8 * i + r8) * N + n0 + 4 * c4);
#pragma unroll
        for (int i = 0; i < 8; ++i) { const int kk = 8 * i + r8; f32x4 v = w[i]; if (kscale) v = v * ((const GAS float*)kscale)[k0 + kk];
            LAS float* d = scr + kk * 33 + 4 * c4; d[0] = v[0]; d[1] = v[1]; d[2] = v[2]; d[3] = v[3]; }
    }
    asm volatile("s_waitcnt lgkmcnt(0)" ::: "memory");
    const int c = lane & 7;
#pragma unroll
    for (int j = 0; j < 4; ++j) { const int n = (lane >> 3) + 8 * j; const LAS float* s = scr + (8 * c) * 33 + n;
        u32x4 o; o.x = cvtpk(s[0 * 33], s[1 * 33]); o.y = cvtpk(s[2 * 33], s[3 * 33]); o.z = cvtpk(s[4 * 33], s[5 * 33]); o.w = cvtpk(s[6 * 33], s[7 * 33]);
        *(GAS u32x4*)(WT + (size_t)(drow0 + n) * K + k0 + 8 * c) = o; }
    asm volatile("s_waitcnt lgkmcnt(0)" ::: "memory");
}
__device__ __forceinline__ int drow_plain(int n0) { return n0; }
__device__ __forceinline__ int drow_swiglu(int n0) { return n0 < DFF ? (n0 >> 7) * 256 + (n0 & 127) : ((n0 - DFF) >> 7) * 256 + 128 + ((n0 - DFF) & 127); }
__device__ __forceinline__ int drow_proj(int n0) { const int L = n0 & 255; return (n0 & ~255) + 128 * ((L >> 5) & 1) + 32 * (L >> 6); }

template <int R> __device__ __forceinline__ void norm_rows_bf16(const float* x, bf16* o, int m0, int rstride, const float* g, const float* shift, const float* scale, int lane) {
    f32x4 v[R][4]; float s[R];
#pragma unroll
    for (int r = 0; r < R; ++r) { const GAS f32x4* xr = (const GAS f32x4*)(x + (size_t)(m0 + r * rstride) * D) + lane;
#pragma unroll
        for (int j = 0; j < 4; ++j) v[r][j] = xr[64 * j]; }
#pragma unroll
    for (int r = 0; r < R; ++r) { s[r] = 0.f;
#pragma unroll
        for (int j = 0; j < 4; ++j) s[r] += (v[r][j].x * v[r][j].x + v[r][j].y * v[r][j].y) + (v[r][j].z * v[r][j].z + v[r][j].w * v[r][j].w); }
#pragma unroll
    for (int of = 1; of < 64; of <<= 1) {
#pragma unroll
        for (int r = 0; r < R; ++r) s[r] += __shfl_xor(s[r], of); }
#pragma unroll
    for (int j = 0; j < 4; ++j) {
        const f32x4 gg = ((const GAS f32x4*)g)[lane + 64 * j], sh = ((const GAS f32x4*)shift)[lane + 64 * j], sc = ((const GAS f32x4*)scale)[lane + 64 * j];
        const f32x4 gs = gg * (sc + 1.0f);
#pragma unroll
        for (int r = 0; r < R; ++r) {
            const float rstd = 1.0f / sqrtf(s[r] * (1.0f / D) + EPS);
            const f32x4 y = v[r][j] * rstd * gs + sh;
            u32x2 w; w.x = cvtpk(y.x, y.y); w.y = cvtpk(y.z, y.w); ((GAS u32x2*)(o + (size_t)(m0 + r * rstride) * D) + lane)[64 * j] = w;
        }
    }
}
template <int R> __device__ __forceinline__ void final_norm_rows(float* x, int m0, int rstride, const float* g, int lane) {
    f32x4 v[R][4]; float s[R];
#pragma unroll
    for (int r = 0; r < R; ++r) { const GAS f32x4* xr = (const GAS f32x4*)(x + (size_t)(m0 + r * rstride) * D) + lane;
#pragma unroll
        for (int j = 0; j < 4; ++j) v[r][j] = xr[64 * j]; }
#pragma unroll
    for (int r = 0; r < R; ++r) { s[r] = 0.f;
#pragma unroll
        for (int j = 0; j < 4; ++j) s[r] += (v[r][j].x * v[r][j].x + v[r][j].y * v[r][j].y) + (v[r][j].z * v[r][j].z + v[r][j].w * v[r][j].w); }
#pragma unroll
    for (int of = 1; of < 64; of <<= 1) {
#pragma unroll
        for (int r = 0; r < R; ++r) s[r] += __shfl_xor(s[r], of); }
#pragma unroll
    for (int j = 0; j < 4; ++j) {
        const f32x4 gg = ((const GAS f32x4*)g)[lane + 64 * j];
#pragma unroll
        for (int r = 0; r < R; ++r) {
            const float rstd = 1.0f / sqrtf(s[r] * (1.0f / D) + EPS);
            ((GAS f32x4*)(x + (size_t)(m0 + r * rstride) * D) + lane)[64 * j] = v[r][j] * rstd * gg;
        }
    }
}

__device__ __forceinline__ f32x4 unpack_lo4(const u32x4 w) { return (f32x4){bf_lo(w.x), bf_hi(w.x), bf_lo(w.y), bf_hi(w.y)}; }
__device__ __forceinline__ f32x4 unpack_hi4(const u32x4 w) { return (f32x4){bf_lo(w.z), bf_hi(w.z), bf_lo(w.w), bf_hi(w.w)}; }
__device__ __forceinline__ float sumsq8(const u32x4 w) { const f32x4 a = unpack_lo4(w), b = unpack_hi4(w); return ((a.x * a.x + a.y * a.y) + (a.z * a.z + a.w * a.w)) + ((b.x * b.x + b.y * b.y) + (b.z * b.z + b.w * b.w)); }
template <int R> __device__ __forceinline__ void norm_rows_bf16in(const bf16* x, bf16* o, int m0, int rstride, const float* g, const float* shift, const float* scale, int lane) {
    u32x4 v[R][2]; float s[R];
#pragma unroll
    for (int r = 0; r < R; ++r) { const GAS u32x4* xr = (const GAS u32x4*)(x + (size_t)(m0 + r * rstride) * D) + lane; v[r][0] = xr[0]; v[r][1] = xr[64]; }
#pragma unroll
    for (int r = 0; r < R; ++r) { s[r] = 0.f;
#pragma unroll
        for (int j = 0; j < 2; ++j) s[r] += sumsq8(v[r][j]); }
#pragma unroll
    for (int of = 1; of < 64; of <<= 1) {
#pragma unroll
        for (int r = 0; r < R; ++r) s[r] += __shfl_xor(s[r], of); }
#pragma unroll
    for (int j = 0; j < 2; ++j) {
        const int i4 = 2 * (lane + 64 * j);
        const f32x4 g0 = ((const GAS f32x4*)g)[i4], g1 = ((const GAS f32x4*)g)[i4 + 1], h0 = ((const GAS f32x4*)shift)[i4], h1 = ((const GAS f32x4*)shift)[i4 + 1], c0 = ((const GAS f32x4*)scale)[i4], c1 = ((const GAS f32x4*)scale)[i4 + 1];
        const f32x4 gs0 = g0 * (c0 + 1.0f), gs1 = g1 * (c1 + 1.0f);
#pragma unroll
        for (int r = 0; r < R; ++r) {
            const float rstd = 1.0f / sqrtf(s[r] * (1.0f / D) + EPS);
            const f32x4 y0 = unpack_lo4(v[r][j]) * rstd * gs0 + h0, y1 = unpack_hi4(v[r][j]) * rstd * gs1 + h1;
            u32x4 w; w.x = cvtpk(y0.x, y0.y); w.y = cvtpk(y0.z, y0.w); w.z = cvtpk(y1.x, y1.y); w.w = cvtpk(y1.z, y1.w);
            ((GAS u32x4*)(o + (size_t)(m0 + r * rstride) * D) + lane)[64 * j] = w;
        }
    }
}
template <int R> __device__ __forceinline__ void final_norm_rows_bf16in(const bf16* x, float* o, int m0, int rstride, const float* g, int lane) {
    u32x4 v[R][2]; float s[R];
#pragma unroll
    for (int r = 0; r < R; ++r) { const GAS u32x4* xr = (const GAS u32x4*)(x + (size_t)(m0 + r * rstride) * D) + lane; v[r][0] = xr[0]; v[r][1] = xr[64]; }
#pragma unroll
    for (int r = 0; r < R; ++r) { s[r] = 0.f;
#pragma unroll
        for (int j = 0; j < 2; ++j) s[r] += sumsq8(v[r][j]); }
#pragma unroll
    for (int of = 1; of < 64; of <<= 1) {
#pragma unroll
        for (int r = 0; r < R; ++r) s[r] += __shfl_xor(s[r], of); }
#pragma unroll
    for (int j = 0; j < 2; ++j) {
        const int i4 = 2 * (lane + 64 * j);
        const f32x4 g0 = ((const GAS f32x4*)g)[i4], g1 = ((const GAS f32x4*)g)[i4 + 1];
#pragma unroll
        for (int r = 0; r < R; ++r) {
            const float rstd = 1.0f / sqrtf(s[r] * (1.0f / D) + EPS);
            GAS f32x4* op = (GAS f32x4*)(o + (size_t)(m0 + r * rstride) * D) + i4;
            op[0] = unpack_lo4(v[r][j]) * rstd * g0; op[1] = unpack_hi4(v[r][j]) * rstd * g1;
        }
    }
}

__device__ __forceinline__ void mod_item(const float* c, const float* w_ada, const float* b_ada, float* mod, int item, int lane) {
    const int ks = item / 36, nb = item % 36, k0 = ks * 64, n0 = nb * 256 + 4 * lane;
    float sv[BATCH];
#pragma unroll
    for (int b = 0; b < BATCH; ++b) { const float x = c[b * D + k0 + lane]; sv[b] = x * __builtin_amdgcn_rcpf(1.0f + __builtin_amdgcn_exp2f(-L2E * x)); }
    f32x4 acc[BATCH];
#pragma unroll
    for (int b = 0; b < BATCH; ++b) acc[b] = (f32x4){0.f, 0.f, 0.f, 0.f};
    const float* wp = w_ada + (size_t)k0 * NMOD + n0;
#pragma unroll 8
    for (int kk = 0; kk < 64; ++kk) {
        const f32x4 w = *(const f32x4*)(wp + (size_t)kk * NMOD);
#pragma unroll
        for (int b = 0; b < BATCH; ++b) { const float s = __builtin_bit_cast(float, __builtin_amdgcn_readlane(__builtin_bit_cast(int, sv[b]), kk)); acc[b] += w * s; }
    }
    if (ks == 0) { const f32x4 bb = *(const f32x4*)(b_ada + n0);
#pragma unroll
        for (int b = 0; b < BATCH; ++b) acc[b] += bb; }
#pragma unroll
    for (int b = 0; b < BATCH; ++b) { float* mp = mod + b * NMOD + n0; atomicAdd(mp, acc[b].x); atomicAdd(mp + 1, acc[b].y); atomicAdd(mp + 2, acc[b].z); atomicAdd(mp + 3, acc[b].w); }
}

constexpr int KP = 144;
constexpr int AT_TILE = 64 * KP, AT_STAGE = 4 * AT_TILE;
constexpr int AT_TB = 2 * AT_STAGE;
static_assert(AT_TB + 257 * 4 <= 131072, "attention LDS map");

__device__ __forceinline__ void attn_bias_table(LAS unsigned char* lds, const float* relb, const float* gqn, const float* gkn, int h, int lane, int tid) {
    LAS float* tb = (LAS float*)(lds + AT_TB);
    {
        const float mq = wave_max(fabsf(gp(gqn)[lane])), mk = wave_max(fabsf(gp(gkn)[lane]));
        float bm = -3.0e38f;
#pragma unroll
        for (int j = 0; j < 5; ++j) { const int idx = lane + 64 * j; bm = fmaxf(bm, idx < 257 ? gp(relb)[h * 257 + idx] : -3.0e38f); }
        bm = wave_max(bm);
        const float B = L2E * (8.1f * mq * mk + bm);
        if (tid < 257) tb[tid] = L2E * gp(relb)[h * 257 + tid] - B;
    }
}
__device__ __forceinline__ void attn_unit(LAS unsigned char* lds, const bf16* PROJ, bf16* YMIX, float* ssq, const float* relb, const float* gqn, const float* gkn,
                                          int b, int h, int c0, int wave, int lane_in, int tid_in) {
    const int lane = launder_v(lane_in), tid = launder_v(tid_in); wave = launder_s(wave);
    const int fr = lane & 15, fq = lane >> 4;
    const LAS float* tb = (const LAS float*)(lds + AT_TB);
    const int r4 = wave & 3, par = wave >> 2;
    const size_t tok0 = (size_t)b * SEQ + (size_t)(c0 + par) * 64 + 16 * r4;
    bf16x8 qf[4][2];
#pragma unroll
    for (int nq = 0; nq < 4; ++nq)
#pragma unroll
        for (int kk = 0; kk < 2; ++kk) qf[nq][kk] = *(const GAS bf16x8*)(PROJ + (tok0 + 128 * nq + fr) * NPROJ + h * 64 + 32 * kk + 8 * fq);
    f32x4 O[4][4], L[4];
    const bf16x8 ones8 = {(short)0x3f80, (short)0x3f80, (short)0x3f80, (short)0x3f80, (short)0x3f80, (short)0x3f80, (short)0x3f80, (short)0x3f80};
#pragma unroll
    for (int md = 0; md < 4; ++md)
#pragma unroll
        for (int nq = 0; nq < 4; ++nq) O[md][nq] = (f32x4){0.f, 0.f, 0.f, 0.f};
#pragma unroll
    for (int nq = 0; nq < 4; ++nq) L[nq] = (f32x4){0.f, 0.f, 0.f, 0.f};
    const int j0 = (c0 == 0) ? 8 : 0;
    const int skey = tid >> 3, sd = (tid & 7) * 8;
    const bf16* Kg = PROJ + ((size_t)b * SEQ + (size_t)((c0 - 8 + j0) * 64 + skey)) * NPROJ + 512 + h * 64 + sd;
    const LAS unsigned char* const rd0 = lds;
    LAS unsigned char* const wr0 = lds + skey * KP + sd * 2;
    const bf16* Kg2 = Kg + (size_t)64 * NPROJ;
    u32x4 pa[4], pb[4];
#define AT_GLOAD(dst) do { asm volatile("global_load_dwordx4 %0, %1, off" : "=&v"(dst[0]) : "v"(Kg) : "memory"); asm volatile("global_load_dwordx4 %0, %1, off offset:1024" : "=&v"(dst[1]) : "v"(Kg) : "memory"); \
        asm volatile("global_load_dwordx4 %0, %1, off" : "=&v"(dst[2]) : "v"(Kg2) : "memory"); asm volatile("global_load_dwordx4 %0, %1, off offset:1024" : "=&v"(dst[3]) : "v"(Kg2) : "memory"); \
        Kg += (size_t)128 * NPROJ; Kg2 += (size_t)128 * NPROJ; } while (0)
#define AT_WAIT4(src) asm volatile("s_waitcnt vmcnt(4)" : "+v"(src[0]), "+v"(src[1]), "+v"(src[2]), "+v"(src[3]) :: "memory")
#define AT_WAIT0(src) asm volatile("s_waitcnt vmcnt(0)" : "+v"(src[0]), "+v"(src[1]), "+v"(src[2]), "+v"(src[3]) :: "memory")
#define AT_STORE(src, stage) do { _Pragma("unroll") for (int q_ = 0; q_ < 4; ++q_) *(LAS u32x4*)(wr0 + (stage) * AT_STAGE + q_ * AT_TILE) = src[q_]; } while (0)
    asm volatile("s_waitcnt vmcnt(0)" ::: "memory");
    AT_GLOAD(pa); AT_WAIT0(pa); AT_STORE(pa, 0);
    AT_GLOAD(pb);
    AT_GLOAD(pa);
#define AT_QK(S, nq) do { _Pragma("unroll") for (int mk = 0; mk < 2; ++mk) _Pragma("unroll") for (int kk = 0; kk < 2; ++kk) S[mk] = __builtin_amdgcn_mfma_f32_16x16x32_bf16(kf[mk][kk], qf[nq][kk], S[mk], 0, 0, 0); } while (0)
#define AT_EXP(S, pb, nq) do { float p[8]; _Pragma("unroll") for (int i = 0; i < 4; ++i) { p[i] = __builtin_amdgcn_exp2f(S[0][i]); p[4 + i] = __builtin_amdgcn_exp2f(S[1][i]); } \
        const u32x4 pk = {cvtpk(p[0], p[1]), cvtpk(p[2], p[3]), cvtpk(p[4], p[5]), cvtpk(p[6], p[7])}; pb = __builtin_bit_cast(bf16x8, pk); } while (0)
#define AT_PV(pb, nq) do { _Pragma("unroll") for (int md = 0; md < 4; ++md) O[md][nq] = __builtin_amdgcn_mfma_f32_16x16x32_bf16(vf[md], pb, O[md][nq], 0, 0, 0); \
        L[nq] = __builtin_amdgcn_mfma_f32_16x16x32_bf16(ones8, pb, L[nq], 0, 0, 0); } while (0)
#define AT_QK_C(S, nq) do { _Pragma("unroll") for (int mk = 0; mk < 2; ++mk) { S[mk] = __builtin_amdgcn_mfma_f32_16x16x32_bf16(kf[mk][0], qf[nq][0], c4v, 0, 0, 0); S[mk] = __builtin_amdgcn_mfma_f32_16x16x32_bf16(kf[mk][1], qf[nq][1], S[mk], 0, 0, 0); } } while (0)
#define AT_INIT_T(S, nq) do { _Pragma("unroll") for (int mk = 0; mk < 2; ++mk) { const int base = 64 * t + 32 * sub - 384 + 16 * mk + 4 * fq - 16 * r4 - fr; \
        _Pragma("unroll") for (int i = 0; i < 4; ++i) { const int idx = base + i; S[mk][i] = tb[idx > 0 ? idx : 0]; } } } while (0)
#define AT_STEP(j, soff) do { \
        const float c0v = tb[0]; const f32x4 c4v = {c0v, c0v, c0v, c0v}; \
        _Pragma("unroll") for (int sub = 0; sub < 2; ++sub) { \
            const LAS unsigned char* kb = rd0 + (soff) + sub * 32 * KP; const LAS unsigned char* vb = kb + AT_TILE; \
            bf16x8 kf[2][2], vf[4]; \
            _Pragma("unroll") for (int mk = 0; mk < 2; ++mk) _Pragma("unroll") for (int kk = 0; kk < 2; ++kk) kf[mk][kk] = *(const LAS bf16x8*)(kb + (16 * mk + fr) * KP + (32 * kk + 8 * fq) * 2); \
            _Pragma("unroll") for (int md = 0; md < 4; ++md) { \
                const v4i16_t lo = __builtin_amdgcn_ds_read_tr16_b64_v4i16((LAS v4i16_t*)(vb + (4 * fq + (fr >> 2)) * KP + (16 * md + 4 * (fr & 3)) * 2)); \
                const v4i16_t hi = __builtin_amdgcn_ds_read_tr16_b64_v4i16((LAS v4i16_t*)(vb + (16 + 4 * fq + (fr >> 2)) * KP + (16 * md + 4 * (fr & 3)) * 2)); \
                vf[md] = (bf16x8){lo[0], lo[1], lo[2], lo[3], hi[0], hi[1], hi[2], hi[3]}; } \
            _Pragma("unroll") for (int nq = 0; nq < 4; ++nq) { \
                const int t = (j) - 2 * nq - par; \
                if (t >= 0 && t <= 8) { f32x4 S[2]; bf16x8 pb; \
                    if (t < 6) { AT_QK_C(S, nq); } else { AT_INIT_T(S, nq); AT_QK(S, nq); } \
                    AT_EXP(S, pb, nq); AT_PV(pb, nq); } \
            } \
        } } while (0)
    typedef short v4i16_t __attribute__((ext_vector_type(4)));
    for (int jp = j0 >> 1; jp < 8; jp += 2) {
        __syncthreads();
        AT_STEP(2 * jp, 0);
        AT_STEP(2 * jp + 1, 2 * AT_TILE);
        if (jp + 2 < 8) AT_WAIT4(pb); else AT_WAIT0(pb);
        AT_STORE(pb, 1);
        if (jp + 3 < 8) AT_GLOAD(pb);
        __syncthreads();
        AT_STEP(2 * jp + 2, AT_STAGE);
        AT_STEP(2 * jp + 3, AT_STAGE + 2 * AT_TILE);
        if (jp + 2 < 8) {
            if (jp + 3 < 8) AT_WAIT4(pa); else AT_WAIT0(pa);
            AT_STORE(pa, 0);
            if (jp + 4 < 8) AT_GLOAD(pa);
        }
    }
#undef AT_GLOAD
#undef AT_WAIT4
#undef AT_WAIT0
#undef AT_LOAD
#undef AT_STORE
#undef AT_STEP
#undef AT_BODY
#undef AT_QK
#undef AT_EXP
#undef AT_PV
#undef AT_QK_C
#undef AT_INIT_T
    const int lane3 = launder_v(lane_in), fr3 = lane3 & 15, fq3 = lane3 >> 4;
#pragma unroll
    for (int nq = 0; nq < 4; ++nq) {
        const float inv = 1.0f / L[nq][0];
        float ss = 0.f;
#pragma unroll
        for (int md = 0; md < 4; ++md) { O[md][nq] = O[md][nq] * inv; const f32x4 x = O[md][nq]; ss += (x[0] * x[0] + x[1] * x[1]) + (x[2] * x[2] + x[3] * x[3]); }
        ss += __shfl_xor(ss, 16); ss += __shfl_xor(ss, 32);
        if (fq3 == 0) (void)__hip_atomic_fetch_add(gp(ssq) + tok0 + 128 * nq + fr3, ss, __ATOMIC_RELAXED, __HIP_MEMORY_SCOPE_AGENT);
#pragma unroll
        for (int md = 0; md < 4; ++md) {
            const f32x4 y = O[md][nq];
            u32x2 w; w.x = cvtpk(y[0], y[1]); w.y = cvtpk(y[2], y[3]);
            *(GAS u32x2*)(YMIX + (tok0 + 128 * nq + fr3) * D + h * 64 + 16 * md + 4 * fq3) = w;
        }
    }
    __syncthreads();
}

__device__ __forceinline__ void conv_unit(const bf16* PROJ, bf16* YMIX, const float* w_conv, const float* b_conv, const float* g_conv, int b, int c, int wave, int lane_in) {
    {
        const int lane2 = launder_v(lane_in); wave = launder_s(wave);
        const int ch0 = 8 * lane2;
        float w0[8], w1[8], w2[8], bc[8], gc[8];
#pragma unroll
        for (int e = 0; e < 8; ++e) { w0[e] = gp(w_conv)[ch0 + e]; w1[e] = gp(w_conv)[512 + ch0 + e]; w2[e] = gp(w_conv)[1024 + ch0 + e]; bc[e] = gp(b_conv)[ch0 + e]; gc[e] = gp(g_conv)[ch0 + e]; }
        const int s0 = c * 64 + 8 * wave;
        const bf16* rowp = PROJ + ((size_t)b * SEQ + s0) * NPROJ + ch0;
        u32x4 xa[10], ga[10], gb[8];
#pragma unroll
        for (int r = 0; r < 10; ++r) { if (r >= 2 || s0 >= 2) { xa[r] = *(const GAS u32x4*)(rowp + (r - 2) * NPROJ + 1536); ga[r] = *(const GAS u32x4*)(rowp + (r - 2) * NPROJ + 2560); }
            else { xa[r] = (u32x4){0u, 0u, 0u, 0u}; ga[r] = xa[r]; } }
#pragma unroll
        for (int r = 0; r < 8; ++r) gb[r] = *(const GAS u32x4*)(rowp + r * NPROJ + 2048);
#define CV_U(dst, xv, gv) do { dst[0] = bf_lo(xv.x) * bf_lo(gv.x); dst[1] = bf_hi(xv.x) * bf_hi(gv.x); dst[2] = bf_lo(xv.y) * bf_lo(gv.y); dst[3] = bf_hi(xv.y) * bf_hi(gv.y); \
        dst[4] = bf_lo(xv.z) * bf_lo(gv.z); dst[5] = bf_hi(xv.z) * bf_hi(gv.z); dst[6] = bf_lo(xv.w) * bf_lo(gv.w); dst[7] = bf_hi(xv.w) * bf_hi(gv.w); } while (0)
        float u0[8], u1[8];
        CV_U(u0, xa[0], ga[0]); CV_U(u1, xa[1], ga[1]);
#pragma unroll
        for (int r = 0; r < 8; ++r) {
            float u2[8]; CV_U(u2, xa[r + 2], ga[r + 2]);
            const u32x4 gbv = gb[r];
            float gbf[8] = {bf_lo(gbv.x), bf_hi(gbv.x), bf_lo(gbv.y), bf_hi(gbv.y), bf_lo(gbv.z), bf_hi(gbv.z), bf_lo(gbv.w), bf_hi(gbv.w)};
            float y[8]; float ss = 0.f;
#pragma unroll
            for (int e = 0; e < 8; ++e) { y[e] = gbf[e] * (w0[e] * u0[e] + w1[e] * u1[e] + w2[e] * u2[e] + bc[e]); ss += y[e] * y[e]; }
            const float rstd = 1.0f / sqrtf(wave_sum(ss) * (1.0f / 512.0f) + EPS);
            u32x4 o;
            o.x = cvtpk(y[0] * rstd * gc[0], y[1] * rstd * gc[1]); o.y = cvtpk(y[2] * rstd * gc[2], y[3] * rstd * gc[3]);
            o.z = cvtpk(y[4] * rstd * gc[4], y[5] * rstd * gc[5]); o.w = cvtpk(y[6] * rstd * gc[6], y[7] * rstd * gc[7]);
            *(GAS u32x4*)(YMIX + ((size_t)b * SEQ + s0 + r) * D + 512 + ch0) = o;
#pragma unroll
            for (int e = 0; e < 8; ++e) { u0[e] = u1[e]; u1[e] = u2[e]; }
        }
#undef CV_U
    }
}

#define XB_TMO      128
#define XB_XCNT(j)  (256  + 64 * (j))
#define XB_XSUB(j)  (1280 + 64 * (j))
#define XB_XGEN(j)  (2304 + 64 * (j))
#define XB_TOP      3328
#define XB_TOPGEN   3392
#define XCD_BAR_WORDS 3456
#define XB_SPIN_CAP (1u << 18)

__device__ __forceinline__ unsigned xb_ld(unsigned* p)              { return __hip_atomic_load(p, __ATOMIC_RELAXED, __HIP_MEMORY_SCOPE_AGENT); }
__device__ __forceinline__ unsigned xb_add(unsigned* p, unsigned v) { return __hip_atomic_fetch_add(p, v, __ATOMIC_RELAXED, __HIP_MEMORY_SCOPE_AGENT); }
__device__ __forceinline__ unsigned xb_xcc_id() { return (unsigned)__builtin_amdgcn_s_getreg((3 << 11) | 20) & 0xFu; }
#define XB_SPIN(cond, bar) do { unsigned _sp = 0; while (cond) { __builtin_amdgcn_s_sleep(1); \
    if ((++_sp & 255u) == 0u) { if (xb_ld(&(bar)[XB_TMO])) break; if (_sp > XB_SPIN_CAP) { atomicAdd(&(bar)[XB_TMO], 1u); break; } } } } while (0)

struct XcdBarrier {
    unsigned* bar; unsigned x;
    volatile LAS unsigned* st;
};

__device__ __forceinline__ XcdBarrier xcd_barrier_post(unsigned* bar, volatile LAS unsigned* st) {
    XcdBarrier b; b.bar = bar; b.x = xb_xcc_id(); b.st = st;
    if (threadIdx.x == 0) (void)xb_add(&bar[XB_XCNT(b.x)], 1u);
    return b;
}
__device__ __forceinline__ void xcd_barrier_complete(unsigned* bar, unsigned x, unsigned& nloc, unsigned& nx) {
    const unsigned G = gridDim.x * gridDim.y * gridDim.z;
    unsigned sum, cnt, mine, sp = 0u;
    for (;;) {
        sum = 0u; cnt = 0u;
#pragma unroll
        for (unsigned j = 0; j < 16; ++j) { const unsigned c = xb_ld(&bar[XB_XCNT(j)]); sum += c; cnt += (c > 0u) ? 1u : 0u; }
        mine = xb_ld(&bar[XB_XCNT(x)]);
        if (sum == G) break;
        __builtin_amdgcn_s_sleep(1);
        if ((++sp & 255u) == 0u) { if (xb_ld(&bar[XB_TMO])) break; if (sp > XB_SPIN_CAP) { atomicAdd(&bar[XB_TMO], 1u); break; } }
    }
    nloc = mine > 0u ? mine : 1u; nx = cnt > 0u ? cnt : 1u;
}

__device__ __forceinline__ void xcd_barrier(const XcdBarrier& b_in, const bool is_t0) {
    XcdBarrier b = b_in; b.x = (unsigned)launder_s(__builtin_amdgcn_readfirstlane((int)b_in.x)); b.bar = launder(b_in.bar);
    asm volatile("s_waitcnt vmcnt(0)" ::: "memory");
    __syncthreads();
    if (is_t0) {
        unsigned* bar = b.bar;
        __builtin_amdgcn_s_waitcnt(0);
        unsigned nloc = b.st[0], nx = b.st[1];
        if (nloc == 0u) { xcd_barrier_complete(bar, b.x, nloc, nx); b.st[0] = nloc; b.st[1] = nx; }
        const unsigned old = xb_add(&bar[XB_XSUB(b.x)], 1u);
        const unsigned gen = old / nloc;
        if (old + 1u == (gen + 1u) * nloc) {
            __builtin_amdgcn_fence(__ATOMIC_RELEASE, "agent");
            asm volatile("s_waitcnt vmcnt(0)" ::: "memory");
            const unsigned og = xb_add(&bar[XB_TOP], 1u);
            const unsigned tg = og / nx;
            if (og + 1u == (tg + 1u) * nx) xb_add(&bar[XB_TOPGEN], 1u);
            else XB_SPIN(xb_ld(&bar[XB_TOPGEN]) == tg, bar);
            __builtin_amdgcn_fence(__ATOMIC_ACQUIRE, "agent");
            xb_add(&bar[XB_XGEN(b.x)], 1u);
            asm volatile("s_waitcnt vmcnt(0)" ::: "memory");
        } else {
            XB_SPIN(xb_ld(&bar[XB_XGEN(b.x)]) == gen, bar);
            __builtin_amdgcn_fence(__ATOMIC_ACQUIRE, "agent");
            asm volatile("s_waitcnt vmcnt(0)" ::: "memory");
        }
    }
    __syncthreads();
}

struct Args {
    const float *x, *c, *w_ada, *b_ada, *g_norm, *w_ffn1_in, *w_ffn1_out, *w_in, *q_norm_g, *k_norm_g, *rel_bias, *w_conv, *b_conv, *g_attn_out, *g_conv_out, *w_out, *w_ffn2_in, *w_ffn2_out, *g_final;
    float* out; unsigned char* ws;
    int rep_norm, rep_up, rep_proj, rep_att, rep_conv, rep_res0, rep_sync, pad;
};

__global__ void __launch_bounds__(NWAVES * 64, 2) fwd_megakernel(Args a_unused) {
#define KARG(f) (kargp[opaque_zero()].f)
    typedef const __attribute__((address_space(4))) Args* kargp_t;
    const kargp_t kargp = (kargp_t)__builtin_amdgcn_kernarg_segment_ptr();
    extern __shared__ __attribute__((aligned(16))) unsigned char lds_raw[];
    cg::grid_group grid = cg::this_grid();
    LAS unsigned char* lds = (LAS unsigned char*)lds_raw;
    const int wave = __builtin_amdgcn_readfirstlane((int)threadIdx.x >> 6);
#define FRESH_LANE() fresh_lane()
#define FRESH_TID() (launder_s(wave) * 64 + fresh_lane())
    constexpr int G = 256; const int bx = blockIdx.x;
    const int gw = bx * NWAVES + wave, NGW = G * NWAVES;
    unsigned char* ws = KARG(ws);
    float* mod = (float*)(ws + WS_MOD);
#define GRID_BAR() xcd_barrier(xbar, FRESH_TID() == 0)
    volatile LAS unsigned* bst = (volatile LAS unsigned*)(lds + 131072 + 64);
    { const int t0 = FRESH_TID(); if (t0 < 2) bst[t0] = 0u; }
    __syncthreads();
    const XcdBarrier xbar = xcd_barrier_post((unsigned*)(ws + WS_BAR), bst);

    {
        const int it = wave * G + bx;
        if (wave < 3 && it < 16 * 36) mod_item(KARG(c), KARG(w_ada), KARG(b_ada), mod, it, FRESH_LANE());
    }
    if (KARG(rep_sync) < 0) grid.sync();
    GRID_BAR();
    {
        constexpr int I_IN = (D / 64) * (2 * DFF / 32), I_OUT = (DFF / 64) * (D / 32), I_PROJ = (D / 64) * (NPROJ / 32), I_WO = (D / 64) * (D / 32);
        constexpr int NITEMS = 2 * I_IN + 2 * I_OUT + I_PROJ + I_WO;
        LAS float* scr = (LAS float*)(lds + wave * 16384); const int lane = FRESH_LANE();
        for (int it = gw; it < NITEMS; it += NGW) {
            int r = it;
            if (r < 2 * I_IN) { const int f = r >= I_IN; r -= f * I_IN; const int nblk = 2 * DFF / 32, kb = r / nblk, nb = r % nblk;
                transpose_item(f ? KARG(w_ffn2_in) : KARG(w_ffn1_in), D, 2 * DFF, (bf16*)(ws + (f ? WS_W2IN : WS_W1IN)), 64 * kb, 32 * nb, drow_swiglu(32 * nb), scr, lane); continue; } r -= 2 * I_IN;
            if (r < 2 * I_OUT) { const int f = r >= I_OUT; r -= f * I_OUT; const int nblk = D / 32, kb = r / nblk, nb = r % nblk;
                transpose_item(f ? KARG(w_ffn2_out) : KARG(w_ffn1_out), DFF, D, (bf16*)(ws + (f ? WS_W2OUT : WS_W1OUT)), 64 * kb, 32 * nb, drow_plain(32 * nb), scr, lane); continue; } r -= 2 * I_OUT;
            if (r < I_PROJ) { const int nblk = NPROJ / 32, kb = r / nblk, nb = r % nblk;
                transpose_item(KARG(w_in), D, NPROJ, (bf16*)(ws + WS_WIN), 64 * kb, 32 * nb, drow_proj(32 * nb), scr, lane); continue; } r -= I_PROJ;
            { const int nblk = D / 32, kb = r / nblk, nb = r % nblk;
                transpose_item(KARG(w_out), D, D, (bf16*)(ws + WS_WOUT), 64 * kb, 32 * nb, drow_plain(32 * nb), scr, lane, kb < 8 ? KARG(g_attn_out) : nullptr); }
        }
    }

    for (int step = 0; step < 3; ++step) {
        unsigned char* wsl = launder(ws);
        float* modl = (float*)(wsl + WS_MOD);
        {
            bf16* XNl = (bf16*)(wsl + WS_XN); const int ln = FRESH_LANE();
            for (int rep = 0; rep < KARG(rep_norm); ++rep) {
            if (step == 0) { const float* xin = launder(KARG(x));
                for (int it = 0, m = gw; it < M / (4 * NGW); ++it, m += 4 * NGW) {
                    const float* mb = modl + (m >> 13) * NMOD + step * 3072;
                    norm_rows_bf16<4>(xin, XNl, m, NGW, KARG(g_norm) + step * D, mb, mb + 1024, ln); }
            } else { const bf16* xs = (const bf16*)(wsl + WS_XS);
                for (int it = 0, m = gw; it < M / (4 * NGW); ++it, m += 4 * NGW) {
                    const float* mb = modl + (m >> 13) * NMOD + step * 3072;
                    norm_rows_bf16in<4>(xs, XNl, m, NGW, KARG(g_norm) + step * D, mb, mb + 1024, ln); }
            } }
        }
        GRID_BAR();
        const bf16* A2; const bf16* B2; int K2;
        if (step != 1) {
            unsigned char* w2 = launder(wsl);
            pg8::Gemm g{(const bf16*)(w2 + WS_XN), (const bf16*)(w2 + (step == 0 ? WS_W1IN : WS_W2IN)), M, 2 * DFF, D}; pg8::StaticOrder S; S.init(M, 2 * DFF, G, bx);
            pg8::EpiSwiglu E{(bf16*)(w2 + WS_ACT), DFF};
            for (int rep = 0; rep < KARG(rep_up); ++rep)
            pg8::gemm_phase<pg8::EpiSwiglu, pg8::StaticOrder, true, true>(lds, g, S, E, FRESH_TID());
            GRID_BAR();
            A2 = (const bf16*)(wsl + WS_ACT); B2 = (const bf16*)(wsl + (step == 0 ? WS_W1OUT : WS_W2OUT)); K2 = DFF;
        } else {
            {
                unsigned char* w2 = launder(wsl);
                pg8::Gemm g{(const bf16*)(w2 + WS_XN), (const bf16*)(w2 + WS_WIN), M, NPROJ, D}; pg8::StaticOrder S; S.init(M, NPROJ, G, bx);
                pg8::EpiProj E{(bf16*)(w2 + WS_ACT), KARG(q_norm_g), KARG(k_norm_g)};
                for (int rep = 0; rep < KARG(rep_proj); ++rep)
                pg8::gemm_phase<pg8::EpiProj, pg8::StaticOrder, true, true>(lds, g, S, E, FRESH_TID());
            }
            GRID_BAR();
            {
                unsigned char* w2 = launder(wsl); const int ln = FRESH_LANE();
                const int vcu = (G % 8 == 0) ? (bx % 8) * (G / 8) + bx / 8 : bx;
                float* ssq = (float*)(w2 + WS_SSQ);
                attn_bias_table(lds, KARG(rel_bias), KARG(q_norm_g), KARG(k_norm_g), ((vcu * 4) >> 4) & 7, FRESH_LANE(), FRESH_TID());
                for (int rep = 0; rep < KARG(rep_att); ++rep)
                for (int j = 0; j < 4; ++j) {
                    const int uu = vcu * 4 + j;
                    attn_unit(lds, (const bf16*)(w2 + WS_ACT), (bf16*)(w2 + WS_XN), rep == 0 ? ssq : ssq + M, KARG(rel_bias), KARG(q_norm_g), KARG(k_norm_g), uu >> 7, (uu >> 4) & 7, 8 * (uu & 15), wave, FRESH_LANE(), FRESH_TID());
                }
                for (int rep = 0; rep < KARG(rep_conv); ++rep)
                for (int uu = vcu * 4; uu < vcu * 4 + 4; ++uu)
                    conv_unit((const bf16*)(w2 + WS_ACT), (bf16*)(w2 + WS_XN), KARG(w_conv), KARG(b_conv), KARG(g_conv_out), uu >> 7, uu & 127, wave, FRESH_LANE());
            }
            GRID_BAR();
            A2 = (const bf16*)(wsl + WS_XN); B2 = (const bf16*)(wsl + WS_WOUT); K2 = D;
        }
        {
            pg8::Gemm g{launder(A2), launder(B2), M, D, K2}; pg8::StaticOrder S; S.init(M, D, G, bx);
            pg8::EpiResid E{launder(KARG(x)), (bf16*)(wsl + WS_XS), launder(modl), (const float*)(wsl + WS_SSQ), step, step == 1 ? 8 : -1};
            for (int rep = 0; rep < (step == 0 ? KARG(rep_res0) : 1); ++rep)
            pg8::gemm_phase<pg8::EpiResid, pg8::StaticOrder, true, true>(lds, g, S, E, FRESH_TID());
        }
        GRID_BAR();
        for (int rep = 0; rep < KARG(rep_sync); ++rep) GRID_BAR();
    }
    { float* outp = launder(KARG(out)); const bf16* xs = (const bf16*)(launder(ws) + WS_XS); const int ln = FRESH_LANE(); for (int it = 0, m = gw; it < M / (4 * NGW); ++it, m += 4 * NGW) final_norm_rows_bf16in<4>(xs, outp, m, NGW, KARG(g_final), ln); }
}

extern "C" void kernel_launch(void* const* d_in, const int* in_sizes, int n_in, void* d_out, int out_size, void* d_ws, size_t ws_size, hipStream_t stream) {
    static int grid = 0;
    if (grid == 0) {
        if (n_in != 19 || out_size != M * D || ws_size < WS_END) { fprintf(stderr, "kernel_launch: unexpected shapes (n_in %d out %d ws %zu)\n", n_in, out_size, ws_size); grid = -1; return; }
        int dev = 0, cus = 0, per_cu = 0;
        (void)hipGetDevice(&dev);
        (void)hipDeviceGetAttribute(&cus, hipDeviceAttributeMultiprocessorCount, dev);
        if (hipFuncSetAttribute((const void*)fwd_megakernel, hipFuncAttributeMaxDynamicSharedMemorySize, LDS_BYTES) != hipSuccess) { fprintf(stderr, "kernel_launch: hipFuncSetAttribute failed\n"); grid = -1; return; }
        if (hipOccupancyMaxActiveBlocksPerMultiprocessor(&per_cu, (const void*)fwd_megakernel, NWAVES * 64, LDS_BYTES) != hipSuccess || per_cu < 1) { fprintf(stderr, "kernel_launch: occupancy query says %d\n", per_cu); per_cu = 1; }
        (void)hipGetLastError();
        grid = cus * per_cu;
        if (grid > 256) grid = 256;
        if (grid != 256) { fprintf(stderr, "kernel_launch: this kernel is built for a 256-workgroup grid, got %d; nothing launched\n", grid); grid = -1; return; }
        fprintf(stderr, "kernel_launch: grid %d (cus %d per_cu %d)\n", grid, cus, per_cu);
    }
    if (grid < 0) return;
    (void)hipMemsetAsync((char*)d_ws + WS_MOD, 0, CTL_ZERO_BYTES, stream);
    Args a{};
    const float** ap = (const float**)&a;
    for (int i = 0; i < 19; ++i) ap[i] = (const float*)d_in[i];
    a.out = (float*)d_out; a.ws = (unsigned char*)d_ws;
    a.rep_norm = KN_NORM; a.rep_up = KN_UP; a.rep_proj = KN_PROJ; a.rep_att = KN_ATT; a.rep_conv = KN_CONV; a.rep_res0 = KN_RES0; a.rep_sync = KN_SYNC; a.pad = 0;
    void* args[] = {&a};
    hipError_t e = hipLaunchCooperativeKernel((const void*)fwd_megakernel, dim3(grid), dim3(NWAVES * 64), args, LDS_BYTES, stream);
    if (e != hipSuccess) fprintf(stderr, "cooperative launch failed: %s (grid %d)\n", hipGetErrorString(e), grid);
}
```
